# Optimizing an MI355X kernel written in HIP

```python
import jax, jax.numpy as jnp
from jax import lax
import numpy as np

D_MODEL = 2048
BATCH = 2
SEQ = 16384
DEPTH = 1

MIX_WIDTH = D_MODEL
POOL_WIDTH = MIX_WIDTH // 2
POOL_WINDOWS = (2, 4, 8, 16)
POOL_GROUP = POOL_WIDTH // len(POOL_WINDOWS)
ATTN_WIDTH = MIX_WIDTH - POOL_WIDTH
HEAD_DIM = 128
N_HEADS = ATTN_WIDTH // HEAD_DIM
DILATED_PATTERNS = ((128, 1), (512, 4), (2048, 16))
MAX_WINDOW = max(w for w, _ in DILATED_PATTERNS)
Q_BLOCK = 128
IN_WIDTH = POOL_WIDTH + 3 * ATTN_WIDTH
D_FF = 4 * D_MODEL
NORM_EPS = 1e-6

kernel_name = "hybrid_pool_dilated_attn_block"


def rmsnorm(x, g):
    xf = x.astype(jnp.float32)
    y = xf * lax.rsqrt(jnp.mean(xf * xf, axis=-1, keepdims=True) + NORM_EPS)
    return (y * g.astype(jnp.float32)).astype(x.dtype)


def alibi_slopes():
    return 2.0 ** (-8.0 * jnp.arange(1, N_HEADS + 1, dtype=jnp.float32) / N_HEADS)


def pool_mixer(u, pool_w, pool_scale):
    B, S, _ = u.shape
    uf = u.astype(jnp.float32)
    cs = jnp.cumsum(uf, axis=1)
    pos = jnp.arange(1, S + 1, dtype=jnp.float32)[None, :, None]
    diffs = []
    for g, w in enumerate(POOL_WINDOWS):
        c = cs[..., g * POOL_GROUP:(g + 1) * POOL_GROUP]
        trailing = c - jnp.pad(c, ((0, 0), (w, 0), (0, 0)))[:, :S]
        mean = trailing / jnp.minimum(pos, float(w))
        diffs.append(mean - uf[..., g * POOL_GROUP:(g + 1) * POOL_GROUP])
    d = jnp.stack(diffs, axis=2).astype(u.dtype)
    y = jnp.einsum('bsgc,gcf->bsgf', d, pool_w).reshape(B, S, POOL_WIDTH)
    return y * pool_scale


def dilated_attention(q, k, v, slopes):
    B, S, H, Dh = q.shape
    scale = Dh ** -0.5
    kp = jnp.pad(k, ((0, 0), (MAX_WINDOW, 0), (0, 0), (0, 0)))
    vp = jnp.pad(v, ((0, 0), (MAX_WINDOW, 0), (0, 0), (0, 0)))
    qi = jnp.arange(Q_BLOCK)

    def block(b0):
        qb = lax.dynamic_slice_in_dim(q, b0, Q_BLOCK, axis=1).astype(jnp.float32) * scale
        kwin = lax.dynamic_slice_in_dim(kp, b0, Q_BLOCK + MAX_WINDOW, axis=1)
        vwin = lax.dynamic_slice_in_dim(vp, b0, Q_BLOCK + MAX_WINDOW, axis=1)
        ms, dens, nums = [], [], []
        for window, dil in DILATED_PATTERNS:
            dist = jnp.arange(window // dil + 1) * dil
            idx = qi[:, None] + MAX_WINDOW - dist[None, :]
            valid = (b0 + qi)[:, None] >= dist[None, :]
            kg = jnp.take(kwin, idx, axis=1).astype(jnp.float32)
            vg = jnp.take(vwin, idx, axis=1).astype(jnp.float32)
            s = jnp.einsum('bqhd,bqjhd->bqhj', qb, kg)
            s = s - slopes[:, None] * dist.astype(jnp.float32)[None, :]
            s = jnp.where(valid[None, :, None, :], s, -jnp.inf)
            m = jnp.max(s, axis=-1)
            p = jnp.exp(s - m[..., None])
            ms.append(m)
            dens.append(jnp.sum(p, axis=-1))
            nums.append(jnp.einsum('bqhj,bqjhd->bqhd', p, vg))
        m_all = jnp.stack(ms)
        w = jnp.exp(m_all - jnp.max(m_all, axis=0))
        den = jnp.sum(w * jnp.stack(dens), axis=0)
        num = jnp.sum(w[..., None] * jnp.stack(nums), axis=0)
        return num / den[..., None]

    starts = jnp.arange(S // Q_BLOCK) * Q_BLOCK
    out = lax.map(block, starts)
    return out.transpose(1, 0, 2, 3, 4).reshape(B, S, H * Dh).astype(q.dtype)


def setup_inputs(seed: int = 0) -> dict:
    key = jax.random.key(seed)
    ks = jax.random.split(key, 12)
    f32 = jnp.float32
    x = jax.random.normal(ks[0], (BATCH, SEQ, D_MODEL), f32)
    norm_mix_g = 1.0 + 0.05 * jax.random.normal(ks[1], (DEPTH, D_MODEL), f32)
    w_in = jax.random.normal(ks[2], (DEPTH, D_MODEL, IN_WIDTH), f32) * D_MODEL ** -0.5
    pool_w = jax.random.normal(ks[3], (DEPTH, len(POOL_WINDOWS), POOL_GROUP, POOL_GROUP), f32) * POOL_GROUP ** -0.5
    pool_scale = 1.0 + 0.1 * jax.random.normal(ks[4], (DEPTH, POOL_WIDTH), f32)
    pool_out_norm_g = 1.0 + 0.05 * jax.random.normal(ks[5], (DEPTH, POOL_WIDTH), f32)
    attn_out_norm_g = 1.0 + 0.05 * jax.random.normal(ks[6], (DEPTH, ATTN_WIDTH), f32)
    w_out = jax.random.normal(ks[7], (DEPTH, MIX_WIDTH, D_MODEL), f32) * MIX_WIDTH ** -0.5
    norm_mlp_g = 1.0 + 0.05 * jax.random.normal(ks[8], (DEPTH, D_MODEL), f32)
    w_up = jax.random.normal(ks[9], (DEPTH, D_MODEL, D_FF), f32) * D_MODEL ** -0.5
    w_down = jax.random.normal(ks[10], (DEPTH, D_FF, D_MODEL), f32) * D_FF ** -0.5
    norm_final_g = 1.0 + 0.05 * jax.random.normal(ks[11], (D_MODEL,), f32)
    return {"x": x, "norm_mix_g": norm_mix_g, "w_in": w_in, "pool_w": pool_w,
            "pool_scale": pool_scale, "pool_out_norm_g": pool_out_norm_g,
            "attn_out_norm_g": attn_out_norm_g, "w_out": w_out, "norm_mlp_g": norm_mlp_g,
            "w_up": w_up, "w_down": w_down, "norm_final_g": norm_final_g}


def reference(x, norm_mix_g, w_in, pool_w, pool_scale, pool_out_norm_g, attn_out_norm_g,
              w_out, norm_mlp_g, w_up, w_down, norm_final_g):
    B, S, _ = x.shape
    slopes = alibi_slopes()
    for l in range(DEPTH):
        h = rmsnorm(x, norm_mix_g[l])
        proj = h @ w_in[l]
        u = proj[..., :POOL_WIDTH]
        qkv = proj[..., POOL_WIDTH:].reshape(B, S, 3, N_HEADS, HEAD_DIM)
        y_pool = rmsnorm(pool_mixer(u, pool_w[l], pool_scale[l]), pool_out_norm_g[l])
        y_attn = rmsnorm(dilated_attention(qkv[:, :, 0], qkv[:, :, 1], qkv[:, :, 2], slopes),
                         attn_out_norm_g[l])
        x = x + jnp.concatenate([y_pool, y_attn], axis=-1) @ w_out[l]
        h = rmsnorm(x, norm_mlp_g[l])
        x = x + jnp.square(jax.nn.relu(h @ w_up[l])) @ w_down[l]
    return rmsnorm(x, norm_final_g)
```

```cpp
#include <hip/hip_runtime.h>
#include <hip/hip_cooperative_groups.h>
#include <cstdio>
#include <cstdint>
#include <cmath>
namespace cg = cooperative_groups;
namespace pg8 {
#define PG8_LAS __attribute__((address_space(3)))
typedef unsigned short bf16_t;
typedef short bf16x8 __attribute__((ext_vector_type(8)));
typedef float f32x4 __attribute__((ext_vector_type(4)));
typedef unsigned u32x4 __attribute__((ext_vector_type(4)));
constexpr int BM = 256, BK = 64, HALF = 128, HTB = HALF * BK * 2  , STAGE_BYTES = 8 * HTB, NXCD = 8, WGM = 8;

__host__ __device__ __forceinline__ int lds_byte(int r, int c) { const int st = (r >> 4) * 2 + (c >> 5), rr = r & 15, cc = c & 31, ob = rr * 64 + cc * 2; return st * 1024 + (ob ^ (((ob >> 9) & 1) << 5)); }
__host__ __device__ __forceinline__ void stage_rc(int b, int& R, int& C) { const int st = b / 1024, sb = b % 1024, swz = sb ^ (((sb >> 9) & 1) << 5); R = (st >> 1) * 16 + swz / 64; C = (st & 1) * 32 + (swz % 64) / 2; }
__host__ __device__ __forceinline__ int perm32(int rho) { const int n = rho >> 4, i = rho & 15; return 8 * (i >> 2) + 4 * n + (i & 3); }

struct Unit { int pm, pn; };
struct Gemm { const bf16_t* A; const bf16_t* Bt; int M, N, K; };

struct StaticOrder {
    int nM, nN, nwg, G, c;
    __host__ __device__ void init(int M, int N, int G_, int c_) { nM = M / BM; nN = N / BM; nwg = nM * nN; G = G_; c = c_; }
    __host__ __device__ bool next(int i, Unit& u) const {
        const long L = (long)i * G + c; if (L >= nwg) return false;
        int wgid = (int)L; { const int q = nwg / NXCD, r = nwg % NXCD, xcd = wgid % NXCD, off = wgid / NXCD; wgid = (xcd < r ? xcd * (q + 1) : r * (q + 1) + (xcd - r) * q) + off; }
        const int nig = WGM * nN, gid = wgid / nig, fm = gid * WGM, gsz = (nM - fm) < WGM ? (nM - fm) : WGM;
        u.pm = fm + ((wgid % nig) % gsz); u.pn = (wgid % nig) / gsz; return true;
    }
    __device__ __forceinline__ void a_ready(const Unit&) const {}
    __device__ __forceinline__ void done(const Unit&) const {}
};

__device__ __forceinline__ unsigned cvt_pk_bf16(float lo, float hi) { unsigned r; asm volatile("v_cvt_pk_bf16_f32 %0, %1, %2" : "=v"(r) : "v"(lo), "v"(hi)); return r; }
typedef float f32x2 __attribute__((ext_vector_type(2)));
__device__ __forceinline__ f32x2 gelu_pk(f32x2 v) {
    const f32x2 av = __builtin_elementwise_abs(v), d = av * 0.2316418882f + 1.0f;
    f32x2 t; t.x = __builtin_amdgcn_rcpf(d.x); t.y = __builtin_amdgcn_rcpf(d.y);
    f32x2 q = t * 0.5307027145f + (-0.7265760135f); q = q * t + 0.7107068705f; q = q * t + (-0.142248368f); q = q * t + 0.127414796f; q = q * t;
    const f32x2 s = (v * v) * (-0.72134752044f);
    f32x2 e; e.x = __builtin_amdgcn_exp2f(s.x); e.y = __builtin_amdgcn_exp2f(s.y);
    const f32x2 m = v * (q * e), r = v - m;
    f32x2 o; o.x = v.x < 0.f ? m.x : r.x; o.y = v.y < 0.f ? m.y : r.y; return o;
}

template <int ACT  > struct EpiBf16 {
    static constexpr bool PERM = true, AFTER_DRAIN = false; static_assert(ACT == 0 || ACT == 1, "EpiBf16: ACT is 0 (none) or 1 (gelu_pk)");
    bf16_t* O; int ldc; const float* bias; int split_cols; size_t split_stride; float scale0;
    __device__ __forceinline__ void operator()(const f32x4 (&acc)[2][2][4][2], const Unit& u, int wr, int wc, int fr, int fq) const {
        const int row0 = u.pm * BM + wr * 64 + fr; int colt = u.pn * BM; bf16_t* base = O;
        float sc = 1.f; if (split_cols) { const int t = colt / split_cols; base += (size_t)t * split_stride; colt -= t * split_cols; if (t == 0) sc = scale0; }
        const int col0 = colt + wc * 32 + 8 * fq, bcol0 = u.pn * BM + wc * 32 + 8 * fq;
        f32x4 bv[2][2];
#pragma unroll
        for (int bj = 0; bj < 2; ++bj)
#pragma unroll
            for (int n = 0; n < 2; ++n) bv[bj][n] = bias ? *(const f32x4*)(bias + bcol0 + bj * HALF + 4 * n) : (f32x4){0.f, 0.f, 0.f, 0.f};
#pragma unroll
        for (int ai = 0; ai < 2; ++ai)
#pragma unroll
            for (int m = 0; m < 4; ++m) { bf16_t* rowp = base + (size_t)(row0 + ai * HALF + m * 16) * ldc + col0;
#pragma unroll
                for (int bj = 0; bj < 2; ++bj) { f32x4 v0 = acc[ai][bj][m][0] + bv[bj][0], v1 = acc[ai][bj][m][1] + bv[bj][1];
                    if (ACT == 1) { f32x2 a = gelu_pk((f32x2){v0[0], v0[1]}), b = gelu_pk((f32x2){v0[2], v0[3]}), c = gelu_pk((f32x2){v1[0], v1[1]}), d = gelu_pk((f32x2){v1[2], v1[3]});
                        v0 = (f32x4){a.x, a.y, b.x, b.y}; v1 = (f32x4){c.x, c.y, d.x, d.y}; }
                    v0 = v0 * sc; v1 = v1 * sc; u32x4 w; w.x = cvt_pk_bf16(v0[0], v0[1]); w.y = cvt_pk_bf16(v0[2], v0[3]); w.z = cvt_pk_bf16(v1[0], v1[1]); w.w = cvt_pk_bf16(v1[2], v1[3]);
                    *(u32x4*)(rowp + bj * HALF) = w; } }
    }
};
template <class Epi, class Sched, bool ALIGN_EPI = false, bool SP2 = false>
__device__ __forceinline__ void gemm_phase(PG8_LAS unsigned char* lds, const Gemm g, const Sched& S, const Epi& E) {
    const int tid = threadIdx.x, wid = __builtin_amdgcn_readfirstlane(tid >> 6), lane = tid & 63, wr = wid >> 2, wc = wid & 3, fr = lane & 15, fq = lane >> 4;
    const int K = g.K, nt = K / BK;
    unsigned voffA[2], voffB[2];
#pragma unroll
    for (int i = 0; i < 2; ++i) { int R, C; stage_rc(tid * 16 + i * 8192, R, C); const int Rb = Epi::PERM ? ((R & ~31) + perm32(R & 31)) : R;
        voffA[i] = (unsigned)(R * K + C) * 2u; voffB[i] = (unsigned)(Rb * K + C) * 2u; }
    const size_t kstep = (size_t)(BK * 2);
    const size_t hstep = (size_t)HALF * K * 2;
    const size_t tstep = 2 * hstep;
    const unsigned ldsw = (unsigned)wid * 1024u;
    const int aoff = lds_byte(wr * 64 + fr, fq * 8), boff = lds_byte(wc * 32 + fr, fq * 8);
#define PG8_SA(b, h) (((b) * 2 + (h)) * HTB)
#define PG8_SB(b, h) ((4 + (b) * 2 + (h)) * HTB)
#define PG8_STAGE(bufoff, gbase, voff) do { _Pragma("unroll") for (int _i = 0; _i < 2; ++_i) \
        __builtin_amdgcn_global_load_lds((const unsigned*)((const char*)(gbase) + (voff)[_i]), (PG8_LAS unsigned*)(lds + (bufoff) + ldsw + _i * 8192), 16, 0, 0); } while (0)
#define PG8_LDA(dst, b, h) do { _Pragma("unroll") for (int m = 0; m < 4; ++m) _Pragma("unroll") for (int k = 0; k < 2; ++k) dst[m][k] = *(const PG8_LAS bf16x8*)(lds + PG8_SA(b, h) + aoff + m * 2048 + k * 1024); } while (0)
#define PG8_LDB(dst, b, h) do { _Pragma("unroll") for (int n = 0; n < 2; ++n) _Pragma("unroll") for (int k = 0; k < 2; ++k) dst[n][k] = *(const PG8_LAS bf16x8*)(lds + PG8_SB(b, h) + boff + n * 2048 + k * 1024); } while (0)
#define PG8_MMA(ai, bj, At, Bt) do { __builtin_amdgcn_s_setprio(1); _Pragma("unroll") for (int m = 0; m < 4; ++m) _Pragma("unroll") for (int n = 0; n < 2; ++n) _Pragma("unroll") for (int k = 0; k < 2; ++k) \
        acc[ai][bj][m][n] = __builtin_amdgcn_mfma_f32_16x16x32_bf16(Bt[n][k], At[m][k], acc[ai][bj][m][n], 0, 0, 0); __builtin_amdgcn_s_setprio(0); } while (0)
#define PG8_WAIT_V(n) asm volatile("s_waitcnt vmcnt(" #n ")" ::: "memory")
#define PG8_WAIT_L(n) asm volatile("s_waitcnt lgkmcnt(" #n ")" ::: "memory")
#define PG8_BAR __builtin_amdgcn_s_barrier()
#define PG8_SCHED __builtin_amdgcn_sched_barrier(0)
    Unit cur, nxt; int ui = 0;
    if (!S.next(0, cur)) return;
    f32x4 acc[2][2][4][2];
#pragma unroll
    for (int a = 0; a < 2; ++a)
#pragma unroll
        for (int b = 0; b < 2; ++b)
#pragma unroll
            for (int m = 0; m < 4; ++m)
#pragma unroll
                for (int n = 0; n < 2; ++n) acc[a][b][m][n] = (f32x4){0.f, 0.f, 0.f, 0.f};
    bf16x8 At[4][2], B0[2][2], B1[2][2];
    const char* cA = (const char*)g.A + (size_t)cur.pm * tstep; const char* cB = (const char*)g.Bt + (size_t)cur.pn * tstep;
    S.a_ready(cur);
    if constexpr (SP2) {
        PG8_STAGE(PG8_SB(0, 0), cB, voffB); PG8_STAGE(PG8_SB(0, 1), cB + hstep, voffB); PG8_STAGE(PG8_SA(0, 0), cA, voffA); PG8_STAGE(PG8_SA(0, 1), cA + hstep, voffA);
        if (wr == 1) PG8_BAR;
        PG8_WAIT_V(2); PG8_BAR;
        PG8_STAGE(PG8_SB(1, 0), cB + kstep, voffB); PG8_STAGE(PG8_SA(1, 0), cA + kstep, voffA); PG8_STAGE(PG8_SB(1, 1), cB + hstep + kstep, voffB);
        PG8_WAIT_V(6); PG8_BAR;
    } else {
        PG8_STAGE(PG8_SB(0, 0), cB, voffB); PG8_STAGE(PG8_SA(0, 0), cA, voffA); PG8_STAGE(PG8_SB(0, 1), cB + hstep, voffB); PG8_STAGE(PG8_SA(0, 1), cA + hstep, voffA);
        if (wr == 1) PG8_BAR;
        PG8_WAIT_V(4); PG8_BAR;
        PG8_STAGE(PG8_SB(1, 0), cB + kstep, voffB); PG8_STAGE(PG8_SA(1, 0), cA + kstep, voffA); PG8_STAGE(PG8_SB(1, 1), cB + hstep + kstep, voffB);
        PG8_WAIT_V(6); PG8_BAR;
    }
    for (;;) {
        const bool has_next = S.next(ui + 1, nxt);
        const char* nA = has_next ? (const char*)g.A + (size_t)nxt.pm * tstep : cA; const char* nB = has_next ? (const char*)g.Bt + (size_t)nxt.pn * tstep : cB;
        for (int t = 0; t < nt; t += 2) {
            const bool last = (t == nt - 2);
            const char* a1 = cA + (size_t)(t + 1) * kstep;
            const char* a2 = last ? nA : cA + (size_t)(t + 2) * kstep; const char* b2 = last ? nB : cB + (size_t)(t + 2) * kstep;
            const char* a3 = a2 + kstep; const char* b3 = b2 + kstep;
            if (last && has_next) S.a_ready(nxt);
            if constexpr (SP2) {
            PG8_LDB(B0, 0, 0); PG8_LDB(B1, 0, 1); PG8_SCHED; PG8_LDA(At, 0, 0); PG8_STAGE(PG8_SA(1, 1), a1 + hstep, voffA);
            PG8_WAIT_V(8); PG8_WAIT_L(0); PG8_BAR; PG8_MMA(0, 0, At, B0); PG8_MMA(0, 1, At, B1); PG8_BAR; PG8_SCHED;
            PG8_LDA(At, 0, 1); PG8_STAGE(PG8_SB(0, 0), b2, voffB); PG8_STAGE(PG8_SB(0, 1), b2 + hstep, voffB); PG8_STAGE(PG8_SA(0, 0), a2, voffA);
            PG8_WAIT_V(8); PG8_WAIT_L(0); PG8_BAR; PG8_MMA(1, 0, At, B0); PG8_MMA(1, 1, At, B1); PG8_BAR; PG8_SCHED;
            PG8_LDB(B0, 1, 0); PG8_LDB(B1, 1, 1); PG8_SCHED; PG8_LDA(At, 1, 0); PG8_STAGE(PG8_SA(0, 1), a2 + hstep, voffA);
            PG8_WAIT_V(8); PG8_WAIT_L(0); PG8_BAR; PG8_MMA(0, 0, At, B0); PG8_MMA(0, 1, At, B1); PG8_BAR; PG8_SCHED;
            PG8_LDA(At, 1, 1); PG8_STAGE(PG8_SB(1, 0), b3, voffB); PG8_STAGE(PG8_SB(1, 1), b3 + hstep, voffB); PG8_STAGE(PG8_SA(1, 0), a3, voffA);
            PG8_WAIT_V(8); PG8_WAIT_L(0); PG8_BAR; PG8_MMA(1, 0, At, B0); PG8_MMA(1, 1, At, B1); PG8_BAR; PG8_SCHED;
            } else {
            PG8_LDB(B0, 0, 0); PG8_SCHED; PG8_LDA(At, 0, 0); PG8_STAGE(PG8_SA(1, 1), a1 + hstep, voffA);
            PG8_WAIT_L(8); PG8_BAR; PG8_WAIT_L(0); PG8_MMA(0, 0, At, B0); PG8_BAR; PG8_SCHED;
            PG8_LDB(B1, 0, 1); PG8_STAGE(PG8_SB(0, 0), b2, voffB);
            PG8_BAR; PG8_WAIT_L(0); PG8_MMA(0, 1, At, B1); PG8_BAR;
            PG8_LDA(At, 0, 1); PG8_STAGE(PG8_SA(0, 0), a2, voffA);
            PG8_BAR; PG8_WAIT_L(0); PG8_MMA(1, 0, At, B0); PG8_BAR; PG8_SCHED;
            PG8_STAGE(PG8_SB(0, 1), b2 + hstep, voffB);
            PG8_WAIT_V(6); PG8_BAR; PG8_MMA(1, 1, At, B1); PG8_BAR;
            PG8_LDB(B0, 1, 0); PG8_SCHED; PG8_LDA(At, 1, 0); PG8_STAGE(PG8_SA(0, 1), a2 + hstep, voffA);
            PG8_WAIT_L(8); PG8_BAR; PG8_WAIT_L(0); PG8_MMA(0, 0, At, B0); PG8_BAR; PG8_SCHED;
            PG8_LDB(B1, 1, 1); PG8_STAGE(PG8_SB(1, 0), b3, voffB);
            PG8_BAR; PG8_WAIT_L(0); PG8_MMA(0, 1, At, B1); PG8_BAR;
            PG8_LDA(At, 1, 1); PG8_STAGE(PG8_SA(1, 0), a3, voffA);
            PG8_BAR; PG8_WAIT_L(0); PG8_MMA(1, 0, At, B0); PG8_BAR; PG8_SCHED;
            PG8_STAGE(PG8_SB(1, 1), b3 + hstep, voffB);
            PG8_WAIT_V(6); PG8_BAR; PG8_MMA(1, 1, At, B1); PG8_BAR;
            }
        }
        if constexpr (ALIGN_EPI) { if (wr == 0) PG8_BAR; }
        if constexpr (!Epi::AFTER_DRAIN) { E(acc, cur, wr, wc, fr, fq); S.done(cur); }
        if (!has_next) break;
#pragma unroll
        for (int a = 0; a < 2; ++a)
#pragma unroll
            for (int b = 0; b < 2; ++b)
#pragma unroll
                for (int m = 0; m < 4; ++m)
#pragma unroll
                    for (int n = 0; n < 2; ++n) acc[a][b][m][n] = (f32x4){0.f, 0.f, 0.f, 0.f};
        cur = nxt; cA = nA; cB = nB; ++ui;
        if constexpr (ALIGN_EPI) { if (wr == 1) PG8_BAR; }
    }
    PG8_WAIT_V(0);
    if constexpr (!ALIGN_EPI) { if (wr == 0) PG8_BAR; }
    PG8_BAR;
    if constexpr (Epi::AFTER_DRAIN) { E.fused(acc, cur, wr, wc, fr, fq, lds, wid, lane); S.done(cur); }
#undef PG8_SA
#undef PG8_SB
#undef PG8_STAGE
#undef PG8_LDA
#undef PG8_LDB
#undef PG8_MMA
#undef PG8_WAIT_V
#undef PG8_WAIT_L
#undef PG8_BAR
#undef PG8_SCHED
}
}
#define PG8_SP2 true
#define PG8_ALIGN true

namespace pg8 {
template <int ACT  > struct EpiBf16Act {
    static constexpr bool PERM = true, AFTER_DRAIN = false;
    bf16_t* O; int ldc;
    __device__ __forceinline__ void operator()(const f32x4 (&acc)[2][2][4][2], const Unit& u, int wr, int wc, int fr, int fq) const {
        const int row0 = u.pm * BM + wr * 64 + fr; const int col0 = u.pn * BM + wc * 32 + 8 * fq;
#pragma unroll
        for (int ai = 0; ai < 2; ++ai)
#pragma unroll
            for (int m = 0; m < 4; ++m) { bf16_t* rowp = O + (size_t)(row0 + ai * HALF + m * 16) * ldc + col0;
#pragma unroll
                for (int bj = 0; bj < 2; ++bj) { f32x4 v0 = acc[ai][bj][m][0], v1 = acc[ai][bj][m][1];
                    if (ACT == 2) {
#pragma unroll
                        for (int e = 0; e < 4; ++e) { const float a = fmaxf(v0[e], 0.f), b = fmaxf(v1[e], 0.f); v0[e] = a * a; v1[e] = b * b; } }
                    u32x4 w; w.x = cvt_pk_bf16(v0[0], v0[1]); w.y = cvt_pk_bf16(v0[2], v0[3]); w.z = cvt_pk_bf16(v1[0], v1[1]); w.w = cvt_pk_bf16(v1[2], v1[3]);
                    *(u32x4*)(rowp + bj * HALF) = w; } }
    }
};
struct EpiResF32 {
    static constexpr bool PERM = false, AFTER_DRAIN = false;
    const float* base; float* out; int ldc;
    __device__ __forceinline__ void operator()(const f32x4 (&acc)[2][2][4][2], const Unit& u, int wr, int wc, int fr, int fq) const {
        const int col0 = u.pn * BM + wc * 32 + 4 * fq;
#pragma unroll
        for (int ai = 0; ai < 2; ++ai)
#pragma unroll
            for (int m = 0; m < 4; ++m) { const int r = ai * HALF + wr * 64 + m * 16 + fr; const size_t off = (size_t)(u.pm * BM + r) * ldc + col0;
#pragma unroll
                for (int bj = 0; bj < 2; ++bj)
#pragma unroll
                    for (int n = 0; n < 2; ++n) { const f32x4 bs = *(const f32x4*)(base + off + bj * HALF + n * 16); *(f32x4*)(out + off + bj * HALF + n * 16) = bs + acc[ai][bj][m][n]; } }
    }
};
}

constexpr int BATCH = 2, SEQ = 16384, DM = 2048, M = BATCH * SEQ;
constexpr int POOLW = 1024, ATTW = 1024, NHEAD = 8, HD = 128, INW = 4096, DFF = 8192;
constexpr float EPS = 1e-6f;
constexpr float QSCALE = 0.08838834764831845f * 1.4426950408889634f;
constexpr float LOG2E = 1.4426950408889634f;
constexpr int NWAVES = 8, NTHREADS = 512;

constexpr size_t MiB = 1u << 20;
constexpr size_t WS_WCAT = 2 * MiB;
constexpr size_t WS_WOUT = 18 * MiB;
constexpr size_t WS_WUP = 26 * MiB;
constexpr size_t WS_WDN = 58 * MiB;
constexpr size_t WS_XN = 96 * MiB;
constexpr size_t WS_PROJ = 224 * MiB;
constexpr size_t WS_CAT = 480 * MiB;
constexpr size_t WS_OPART = 608 * MiB;
constexpr size_t WS_ML = 800 * MiB;
constexpr size_t WS_H = 224 * MiB;
constexpr size_t WS_END = 806 * MiB;

constexpr int RING_BYTES = 131072;
constexpr int LDS_BYTES = 147456;

#define LAS __attribute__((address_space(3)))
typedef unsigned short bf16;
typedef unsigned v4u __attribute__((ext_vector_type(4)));
typedef unsigned v2u __attribute__((ext_vector_type(2)));
typedef float f32x4 __attribute__((ext_vector_type(4)));
typedef float f32x2 __attribute__((ext_vector_type(2)));
typedef float f32x16 __attribute__((ext_vector_type(16)));
typedef short bf16x8 __attribute__((ext_vector_type(8)));
typedef short s16x4 __attribute__((ext_vector_type(4)));

__device__ __forceinline__ unsigned f2bf(float f) { unsigned u = __builtin_bit_cast(unsigned, f); return (u + 0x7fffu + ((u >> 16) & 1u)) >> 16; }
__device__ __forceinline__ unsigned pk2(float lo, float hi) { return f2bf(lo) | (f2bf(hi) << 16); }
__device__ __forceinline__ float bflo(unsigned w) { return __builtin_bit_cast(float, w << 16); }
__device__ __forceinline__ float bfhi(unsigned w) { return __builtin_bit_cast(float, w & 0xffff0000u); }
__device__ __forceinline__ float wave_sum(float v) {
#pragma unroll
    for (int o = 1; o < 64; o <<= 1) v += __shfl_xor(v, o);
    return v;
}

__device__ __forceinline__ void p0_transpose_item(const float* W, int ldw, int K, int N, bf16* WT, int row_off, int nscale, float sc, LAS float* scr, int item, int lane) {
    const int nblk = N / 32, kb = item / nblk, nb = item % nblk, k0 = 64 * kb, n0 = 32 * nb;
    const float s = (n0 < nscale) ? sc : 1.0f;
#pragma unroll 8
    for (int i = 0; i < 32; ++i) { const int kk = 2 * i + (lane >> 5); scr[kk * 33 + (lane & 31)] = W[(size_t)(k0 + kk) * ldw + n0 + (lane & 31)] * s; }
    asm volatile("s_waitcnt lgkmcnt(0)" ::: "memory");
    const int c = lane & 7;
#pragma unroll
    for (int j = 0; j < 4; ++j) { const int n = (lane >> 3) + 8 * j; const LAS float* sp = scr + (8 * c) * 33 + n;
        v4u o; o.x = pk2(sp[0 * 33], sp[1 * 33]); o.y = pk2(sp[2 * 33], sp[3 * 33]); o.z = pk2(sp[4 * 33], sp[5 * 33]); o.w = pk2(sp[6 * 33], sp[7 * 33]);
        *(v4u*)(WT + (size_t)(row_off + n0 + n) * K + k0 + 8 * c) = o; }
    asm volatile("s_waitcnt lgkmcnt(0)" ::: "memory");
}
template <bool BF> __device__ __forceinline__ void rms_row(const float* xrow, const float* g, void* orow, int lane) {
    const f32x4* xr = (const f32x4*)xrow + lane; const f32x4* gr = (const f32x4*)g + lane;
    f32x4 v[8]; float s = 0.f;
#pragma unroll
    for (int j = 0; j < 8; ++j) { v[j] = xr[64 * j]; s += (v[j].x * v[j].x + v[j].y * v[j].y) + (v[j].z * v[j].z + v[j].w * v[j].w); }
    const float rstd = 1.0f / sqrtf(wave_sum(s) * (1.0f / DM) + EPS);
#pragma unroll
    for (int j = 0; j < 8; ++j) { const f32x4 gg = gr[64 * j]; const f32x4 o = v[j] * rstd * gg;
        if (BF) { v2u w; w.x = pk2(o.x, o.y); w.y = pk2(o.z, o.w); ((v2u*)orow)[64 * j + lane] = w; }
        else ((f32x4*)orow)[64 * j + lane] = o; }
}

constexpr int VSTRIDE = 272;
constexpr int VTILE_BYTES = 32 * VSTRIDE;
__device__ __forceinline__ int crow(int r, int hi) { return (r & 3) + 8 * (r >> 2) + 4 * hi; }
__device__ __forceinline__ s16x4 vtr(const LAS char* p) { typedef short v4i16_t __attribute__((ext_vector_type(4))); return __builtin_bit_cast(s16x4, __builtin_amdgcn_ds_read_tr16_b64_v4i16((LAS v4i16_t*)p)); }

__device__ __forceinline__ void attn_wave_unit(const bf16* __restrict__ proj, bf16* __restrict__ opart, f32x2* __restrict__ ml, int wu, LAS char* vl, int lane) {
    const int p = wu >> 13, rem = wu & 8191, bh = rem >> 9, b = bh >> 3, h = bh & 7, blk = rem & 511;
    const int ls = 2 * p, r = blk >> (9 - ls), ib = blk & ((512 >> ls) - 1);
    const int q = lane & 31, hi = lane >> 5;
    const size_t rowbase = (size_t)b * SEQ + r;
    const size_t qrow = rowbase + ((size_t)(ib * 32 + q) << ls);
    bf16x8 qf[8];
    { const bf16* Qp = proj + qrow * INW + POOLW + h * HD + 8 * hi;
#pragma unroll
      for (int s = 0; s < 8; ++s) qf[s] = *(const bf16x8*)(Qp + 16 * s); }
    float m = -1e30f, l = 0.f;
    f32x16 o[4];
#pragma unroll
    for (int c = 0; c < 4; ++c)
#pragma unroll
        for (int e = 0; e < 16; ++e) o[c][e] = 0.f;
    const float sl = __builtin_amdgcn_exp2f(-(float)(h + 1)) * LOG2E * (float)(1 << ls);
    const LAS char* vrd = vl + (4 * hi + ((lane & 15) >> 2)) * VSTRIDE + (16 * ((lane >> 4) & 1) + 4 * (lane & 3)) * 2;
    LAS char* vwr = vl + (lane >> 4) * VSTRIDE + (lane & 15) * 16;
    const int kt0 = ib >= 4 ? 0 : 4 - ib;
    for (int kt = kt0; kt < 5; ++kt) {
        const int ik0 = ib * 32 - 128 + 32 * kt;
        bf16x8 kf[8];
        { const bf16* Kp = proj + (rowbase + ((size_t)(ik0 + q) << ls)) * INW + POOLW + ATTW + h * HD + 8 * hi;
#pragma unroll
          for (int s = 0; s < 8; ++s) kf[s] = *(const bf16x8*)(Kp + 16 * s); }
        v4u vv[8];
        { const bf16* Vp = proj + (rowbase + ((size_t)(ik0 + (lane >> 4)) << ls)) * INW + POOLW + 2 * ATTW + h * HD + (lane & 15) * 8;
#pragma unroll
          for (int j = 0; j < 8; ++j) vv[j] = *(const v4u*)(Vp + ((size_t)(4 * j) << ls) * INW); }
        f32x16 s;
#pragma unroll
        for (int e = 0; e < 16; ++e) s[e] = 0.f;
#pragma unroll
        for (int ss = 0; ss < 8; ++ss) s = __builtin_amdgcn_mfma_f32_32x32x16_bf16(kf[ss], qf[ss], s, 0, 0, 0);
        const int dbase = q + 128 - 32 * kt;
        float mx = -INFINITY;
#pragma unroll
        for (int e = 0; e < 16; ++e) { const int dl = dbase - crow(e, hi); float v = s[e] - sl * (float)dl; v = (dl < 0 || dl > 128) ? -INFINITY : v; s[e] = v; mx = fmaxf(mx, v); }
        mx = fmaxf(mx, __shfl_xor(mx, 32));
        const float mn = fmaxf(m, mx), alpha = __builtin_amdgcn_exp2f(m - mn);
        m = mn;
        float ps = 0.f;
#pragma unroll
        for (int e = 0; e < 16; ++e) { s[e] = __builtin_amdgcn_exp2f(s[e] - mn); ps += s[e]; }
        l = l * alpha + ps;
#pragma unroll
        for (int c = 0; c < 4; ++c)
#pragma unroll
            for (int e = 0; e < 16; ++e) o[c][e] *= alpha;
        v4u pw0, pw1;
        pw0.x = pk2(s[0], s[1]); pw0.y = pk2(s[2], s[3]); pw0.z = pk2(s[4], s[5]); pw0.w = pk2(s[6], s[7]);
        pw1.x = pk2(s[8], s[9]); pw1.y = pk2(s[10], s[11]); pw1.z = pk2(s[12], s[13]); pw1.w = pk2(s[14], s[15]);
        const bf16x8 pf0 = __builtin_bit_cast(bf16x8, pw0), pf1 = __builtin_bit_cast(bf16x8, pw1);
#pragma unroll
        for (int j = 0; j < 8; ++j) *(LAS v4u*)(vwr + 4 * j * VSTRIDE) = vv[j];
        asm volatile("s_waitcnt lgkmcnt(0)" ::: "memory");
#pragma unroll
        for (int c = 0; c < 4; ++c) {
            const s16x4 a0 = vtr(vrd + c * 64), a1 = vtr(vrd + c * 64 + 8 * VSTRIDE);
            const s16x4 b0 = vtr(vrd + c * 64 + 16 * VSTRIDE), b1 = vtr(vrd + c * 64 + 24 * VSTRIDE);
            const bf16x8 vf0 = (bf16x8){a0[0], a0[1], a0[2], a0[3], a1[0], a1[1], a1[2], a1[3]};
            const bf16x8 vf1 = (bf16x8){b0[0], b0[1], b0[2], b0[3], b1[0], b1[1], b1[2], b1[3]};
            o[c] = __builtin_amdgcn_mfma_f32_32x32x16_bf16(vf0, pf0, o[c], 0, 0, 0);
            o[c] = __builtin_amdgcn_mfma_f32_32x32x16_bf16(vf1, pf1, o[c], 0, 0, 0);
        }
        asm volatile("s_waitcnt lgkmcnt(0)" ::: "memory");
    }
    const float lt = l + __shfl_xor(l, 32), inv = 1.0f / lt;
    bf16* Op = opart + ((size_t)p * M + qrow) * ATTW + h * HD + 4 * hi;
#pragma unroll
    for (int c = 0; c < 4; ++c)
#pragma unroll
        for (int g4 = 0; g4 < 4; ++g4) { v2u w; w.x = pk2(o[c][4 * g4] * inv, o[c][4 * g4 + 1] * inv); w.y = pk2(o[c][4 * g4 + 2] * inv, o[c][4 * g4 + 3] * inv);
            *(v2u*)(Op + 32 * c + 8 * g4) = w; }
    if (hi == 0) ml[((size_t)p * M + qrow) * NHEAD + h] = (f32x2){m, lt};
}

__device__ __forceinline__ void merge_row(const bf16* __restrict__ proj, const bf16* __restrict__ opart, const f32x2* __restrict__ ml, const float* __restrict__ gp, const float* __restrict__ ga,
                                          bf16* __restrict__ cat, int row, int lane) {
    const int t = row & (SEQ - 1), c0 = lane * 16;
    float y[16];
    {
        const int w = 2 << (lane >> 4), cnt = (t + 1 < w) ? t + 1 : w;
        float acc[16], z0[16];
#pragma unroll
        for (int j = 0; j < 16; ++j) { acc[j] = 0.f; z0[j] = 0.f; }
        for (int i = 0; i < 16; ++i) {
            if (i < cnt) {
                const v4u* zp = (const v4u*)(proj + (size_t)(row - i) * INW + c0);
                const v4u a = zp[0], b = zp[1];
                float f[16] = {bflo(a.x), bfhi(a.x), bflo(a.y), bfhi(a.y), bflo(a.z), bfhi(a.z), bflo(a.w), bfhi(a.w), bflo(b.x), bfhi(b.x), bflo(b.y), bfhi(b.y), bflo(b.z), bfhi(b.z), bflo(b.w), bfhi(b.w)};
#pragma unroll
                for (int j = 0; j < 16; ++j) { acc[j] += f[j]; if (i == 0) z0[j] = f[j]; }
            }
        }
        const float ic = 1.0f / (float)cnt;
#pragma unroll
        for (int j = 0; j < 16; ++j) y[j] = acc[j] * ic - z0[j];
    }
    {
        float ss = 0.f;
#pragma unroll
        for (int j = 0; j < 16; ++j) ss += y[j] * y[j];
        const float rstd = 1.0f / sqrtf(wave_sum(ss) * (1.0f / POOLW) + EPS);
        const f32x4* g4 = (const f32x4*)(gp + c0);
        v4u o0, o1; const f32x4 ga0 = g4[0], ga1 = g4[1], ga2 = g4[2], ga3 = g4[3];
        o0.x = pk2(y[0] * rstd * ga0.x, y[1] * rstd * ga0.y); o0.y = pk2(y[2] * rstd * ga0.z, y[3] * rstd * ga0.w);
        o0.z = pk2(y[4] * rstd * ga1.x, y[5] * rstd * ga1.y); o0.w = pk2(y[6] * rstd * ga1.z, y[7] * rstd * ga1.w);
        o1.x = pk2(y[8] * rstd * ga2.x, y[9] * rstd * ga2.y); o1.y = pk2(y[10] * rstd * ga2.z, y[11] * rstd * ga2.w);
        o1.z = pk2(y[12] * rstd * ga3.x, y[13] * rstd * ga3.y); o1.w = pk2(y[14] * rstd * ga3.z, y[15] * rstd * ga3.w);
        v4u* cp = (v4u*)(cat + (size_t)row * DM + c0); cp[0] = o0; cp[1] = o1;
    }
    {
        const int hd = lane >> 3;
        const f32x2 s0 = ml[((size_t)0 * M + row) * NHEAD + hd], s1 = ml[((size_t)1 * M + row) * NHEAD + hd], s2 = ml[((size_t)2 * M + row) * NHEAD + hd];
        const float mx = fmaxf(s0.x, fmaxf(s1.x, s2.x));
        float w0 = __builtin_amdgcn_exp2f(s0.x - mx) * s0.y, w1 = __builtin_amdgcn_exp2f(s1.x - mx) * s1.y, w2 = __builtin_amdgcn_exp2f(s2.x - mx) * s2.y;
        const float iw = 1.0f / (w0 + w1 + w2); w0 *= iw; w1 *= iw; w2 *= iw;
#pragma unroll
        for (int j = 0; j < 16; ++j) y[j] = 0.f;
#pragma unroll
        for (int i = 0; i < 3; ++i) {
            const float wi = i == 0 ? w0 : (i == 1 ? w1 : w2);
            const v4u* op = (const v4u*)(opart + ((size_t)i * M + row) * ATTW + c0);
            const v4u a = op[0], b = op[1];
            float f[16] = {bflo(a.x), bfhi(a.x), bflo(a.y), bfhi(a.y), bflo(a.z), bfhi(a.z), bflo(a.w), bfhi(a.w), bflo(b.x), bfhi(b.x), bflo(b.y), bfhi(b.y), bflo(b.z), bfhi(b.z), bflo(b.w), bfhi(b.w)};
#pragma unroll
            for (int j = 0; j < 16; ++j) y[j] += wi * f[j];
        }
        float ss = 0.f;
#pragma unroll
        for (int j = 0; j < 16; ++j) ss += y[j] * y[j];
        const float rstd = 1.0f / sqrtf(wave_sum(ss) * (1.0f / ATTW) + EPS);
        const f32x4* g4 = (const f32x4*)(ga + c0);
        v4u o0, o1; const f32x4 ga0 = g4[0], ga1 = g4[1], ga2 = g4[2], ga3 = g4[3];
        o0.x = pk2(y[0] * rstd * ga0.x, y[1] * rstd * ga0.y); o0.y = pk2(y[2] * rstd * ga0.z, y[3] * rstd * ga0.w);
        o0.z = pk2(y[4] * rstd * ga1.x, y[5] * rstd * ga1.y); o0.w = pk2(y[6] * rstd * ga1.z, y[7] * rstd * ga1.w);
        o1.x = pk2(y[8] * rstd * ga2.x, y[9] * rstd * ga2.y); o1.y = pk2(y[10] * rstd * ga2.z, y[11] * rstd * ga2.w);
        o1.z = pk2(y[12] * rstd * ga3.x, y[13] * rstd * ga3.y); o1.w = pk2(y[14] * rstd * ga3.z, y[15] * rstd * ga3.w);
        v4u* cp = (v4u*)(cat + (size_t)row * DM + POOLW + c0); cp[0] = o0; cp[1] = o1;
    }
}

#ifndef MK_N_LAUNCHES
#define MK_N_LAUNCHES 1
#endif
constexpr int N_PHASES = 9;
struct Args { const float* in[12]; float* out; unsigned char* ws; int ph_lo, ph_hi; };

__global__ void __launch_bounds__(NTHREADS, 2) fwd_mega(Args args) {
    extern __shared__ __attribute__((aligned(16))) unsigned char lds_raw[];
    LAS unsigned char* lds = (LAS unsigned char*)lds_raw;
    const int tid = threadIdx.x, lane = tid & 63, wave = __builtin_amdgcn_readfirstlane(tid >> 6);
    const int G = gridDim.x, bx = blockIdx.x;
    const int gw = bx * NWAVES + wave, NGW = G * NWAVES;
    unsigned char* ws = args.ws;
    const float* x = args.in[0]; const float* g_mix = args.in[1]; const float* w_in = args.in[2]; const float* pool_w = args.in[3]; const float* pool_scale = args.in[4];
    const float* g_pool = args.in[5]; const float* g_attn = args.in[6]; const float* w_out = args.in[7]; const float* g_mlp = args.in[8]; const float* w_up = args.in[9];
    const float* w_down = args.in[10]; const float* g_fin = args.in[11];
    float* out = args.out;
    bf16* WCAT = (bf16*)(ws + WS_WCAT); bf16* WOUT = (bf16*)(ws + WS_WOUT); bf16* WUP = (bf16*)(ws + WS_WUP); bf16* WDN = (bf16*)(ws + WS_WDN);
    bf16* XN = (bf16*)(ws + WS_XN); bf16* PROJ = (bf16*)(ws + WS_PROJ); bf16* CAT = (bf16*)(ws + WS_CAT); bf16* OPART = (bf16*)(ws + WS_OPART);
    f32x2* ML = (f32x2*)(ws + WS_ML); bf16* HB = (bf16*)(ws + WS_H);
    const int lo = args.ph_lo, hi = args.ph_hi;
#define IN(k) (lo <= (k) && (k) < hi)
#define SEAM(k) do { if (IN(k) && IN((k) + 1)) cg::this_grid().sync(); } while (0)

    if (IN(0)) {
        {
            LAS float* wt = (LAS float*)lds;
            const int f = tid & 255, kh = tid >> 8;
            for (int tile = bx; tile < 512; tile += G) {
                const int g = tile >> 7, k0 = (tile & 127) * 16;
#pragma unroll
                for (int j = 0; j < 8; ++j) { const int idx = tid + 512 * j, kk = idx >> 8, c = idx & 255; wt[kk * 256 + c] = w_in[(size_t)(k0 + kk) * INW + g * 256 + c]; }
                __syncthreads();
                float acc[8];
#pragma unroll
                for (int kk = 0; kk < 8; ++kk) acc[kk] = 0.f;
                const float* pw = pool_w + (size_t)g * 65536 + f;
                for (int c = 0; c < 256; c += 4) {
                    const float p0 = pw[(c + 0) * 256], p1 = pw[(c + 1) * 256], p2 = pw[(c + 2) * 256], p3 = pw[(c + 3) * 256];
#pragma unroll
                    for (int kk = 0; kk < 8; ++kk) { const f32x4 v = *(const LAS f32x4*)(wt + (8 * kh + kk) * 256 + c); acc[kk] += (p0 * v.x + p1 * v.y) + (p2 * v.z + p3 * v.w); }
                }
                const float sc = pool_scale[g * 256 + f];
                v4u o; o.x = pk2(acc[0] * sc, acc[1] * sc); o.y = pk2(acc[2] * sc, acc[3] * sc); o.z = pk2(acc[4] * sc, acc[5] * sc); o.w = pk2(acc[6] * sc, acc[7] * sc);
                *(v4u*)(WCAT + (size_t)(g * 256 + f) * DM + k0 + 8 * kh) = o;
                __syncthreads();
            }
        }
        {
            LAS float* scr = (LAS float*)(lds + wave * 16384);
            constexpr int I_QKV = (DM / 64) * (3 * ATTW / 32), I_O = (DM / 64) * (DM / 32), I_U = (DM / 64) * (DFF / 32), I_D = (DFF / 64) * (DM / 32);
            for (int it = gw; it < I_QKV + I_O + I_U + I_D; it += NGW) {
                int r = it;
                if (r < I_QKV) { p0_transpose_item(w_in + POOLW, INW, DM, 3 * ATTW, WCAT, POOLW, ATTW, QSCALE, scr, r, lane); continue; } r -= I_QKV;
                if (r < I_O) { p0_transpose_item(w_out, DM, DM, DM, WOUT, 0, 0, 1.f, scr, r, lane); continue; } r -= I_O;
                if (r < I_U) { p0_transpose_item(w_up, DFF, DM, DFF, WUP, 0, 0, 1.f, scr, r, lane); continue; } r -= I_U;
                p0_transpose_item(w_down, DM, DFF, DM, WDN, 0, 0, 1.f, scr, r, lane);
            }
        }
        for (int m = gw; m < M; m += NGW) rms_row<true>(x + (size_t)m * DM, g_mix, XN + (size_t)m * DM, lane);
    }
    SEAM(0);
    if (IN(1)) {
        __syncthreads();
        pg8::Gemm g{XN, WCAT, M, INW, DM}; pg8::StaticOrder S; S.init(M, INW, G, bx);
        pg8::EpiBf16Act<0> E{PROJ, INW};
        pg8::gemm_phase<pg8::EpiBf16Act<0>, pg8::StaticOrder, PG8_ALIGN, PG8_SP2>(lds, g, S, E);
    }
    SEAM(1);
    if (IN(2)) {
        LAS char* vl = (LAS char*)lds + wave * VTILE_BYTES;
        for (int u = bx; u < 3072; u += G) attn_wave_unit(PROJ, OPART, ML, u * 8 + wave, vl, lane);
    }
    SEAM(2);
    if (IN(3)) {
        for (int m = gw; m < M; m += NGW) merge_row(PROJ, OPART, ML, g_pool, g_attn, CAT, m, lane);
    }
    SEAM(3);
    if (IN(4)) {
        __syncthreads();
        pg8::Gemm g{CAT, WOUT, M, DM, DM}; pg8::StaticOrder S; S.init(M, DM, G, bx);
        pg8::EpiResF32 E{x, out, DM};
        pg8::gemm_phase<pg8::EpiResF32, pg8::StaticOrder, PG8_ALIGN, PG8_SP2>(lds, g, S, E);
    }
    SEAM(4);
    if (IN(5)) {
        for (int m = gw; m < M; m += NGW) rms_row<true>(out + (size_t)m * DM, g_mlp, XN + (size_t)m * DM, lane);
    }
    SEAM(5);
    if (IN(6)) {
        __syncthreads();
        pg8::Gemm g{XN, WUP, M, DFF, DM}; pg8::StaticOrder S; S.init(M, DFF, G, bx);
        pg8::EpiBf16Act<2> E{HB, DFF};
        pg8::gemm_phase<pg8::EpiBf16Act<2>, pg8::StaticOrder, PG8_ALIGN, PG8_SP2>(lds, g, S, E);
    }
    SEAM(6);
    if (IN(7)) {
        __syncthreads();
        pg8::Gemm g{HB, WDN, M, DM, DFF}; pg8::StaticOrder S; S.init(M, DM, G, bx);
        pg8::EpiResF32 E{out, out, DM};
        pg8::gemm_phase<pg8::EpiResF32, pg8::StaticOrder, PG8_ALIGN, PG8_SP2>(lds, g, S, E);
    }
    SEAM(7);
    if (IN(8)) {
        for (int m = gw; m < M; m += NGW) rms_row<false>(out + (size_t)m * DM, g_fin, out + (size_t)m * DM, lane);
    }
#undef IN
#undef SEAM
}

extern "C" void kernel_launch(void* const* d_in, const int* in_sizes, int n_in, void* d_out, int out_size, void* d_ws, size_t ws_size, hipStream_t stream) {
    static int grid = 0;
    if (grid == 0) {
        if (n_in != 12 || in_sizes[0] != M * DM || out_size != M * DM || ws_size < WS_END) { fprintf(stderr, "kernel_launch: unexpected shapes (n_in %d, in0 %d, out %d, ws %zu); nothing launched\n", n_in, n_in > 0 ? in_sizes[0] : -1, out_size, ws_size); grid = -1; return; }
        int dev = 0, cus = 0, per_cu = 0;
        if (hipGetDevice(&dev) != hipSuccess || hipDeviceGetAttribute(&cus, hipDeviceAttributeMultiprocessorCount, dev) != hipSuccess) { fprintf(stderr, "kernel_launch: device query failed\n"); grid = -1; return; }
        if (hipFuncSetAttribute((const void*)fwd_mega, hipFuncAttributeMaxDynamicSharedMemorySize, LDS_BYTES) != hipSuccess) { fprintf(stderr, "kernel_launch: hipFuncSetAttribute failed\n"); grid = -1; return; }
        if (hipOccupancyMaxActiveBlocksPerMultiprocessor(&per_cu, (const void*)fwd_mega, NTHREADS, LDS_BYTES) != hipSuccess || per_cu < 1) { fprintf(stderr, "kernel_launch: occupancy query gave %d\n", per_cu); per_cu = 1; }
        (void)hipGetLastError();
        grid = cus * per_cu;
    }
    if (grid < 0) return;
    Args a{};
    for (int i = 0; i < 12; ++i) a.in[i] = (const float*)d_in[i];
    a.out = (float*)d_out; a.ws = (unsigned char*)d_ws;
#if MK_N_LAUNCHES == 1
    a.ph_lo = 0; a.ph_hi = N_PHASES;
    void* kargs[] = {&a};
    hipError_t e = hipLaunchCooperativeKernel((const void*)fwd_mega, dim3(grid), dim3(NTHREADS), kargs, LDS_BYTES, stream);
    if (e != hipSuccess) fprintf(stderr, "kernel_launch: cooperative launch failed: %s (grid %d)\n", hipGetErrorString(e), grid);
#else
    for (int ph = 0; ph < N_PHASES; ++ph) {
        a.ph_lo = ph; a.ph_hi = ph + 1;
        hipLaunchKernelGGL(fwd_mega, dim3(grid), dim3(NTHREADS), LDS_BYTES, stream, a);
    }
#endif
}
```

```cpp
#include <hip/hip_runtime.h>
#include <hip/hip_cooperative_groups.h>
#include <cstdio>
#include <cstdint>
#include <cmath>
namespace cg = cooperative_groups;
namespace pg8 {
#define PG8_LAS __attribute__((address_space(3)))
typedef unsigned short bf16_t;
typedef short bf16x8 __attribute__((ext_vector_type(8)));
typedef float f32x4 __attribute__((ext_vector_type(4)));
typedef unsigned u32x4 __attribute__((ext_vector_type(4)));
constexpr int BM = 256, BK = 64, HALF = 128, HTB = HALF * BK * 2  , STAGE_BYTES = 8 * HTB, NXCD = 8, WGM = 8;

__host__ __device__ __forceinline__ int lds_byte(int r, int c) { const int st = (r >> 4) * 2 + (c >> 5), rr = r & 15, cc = c & 31, ob = rr * 64 + cc * 2; return st * 1024 + (ob ^ (((ob >> 9) & 1) << 5)); }
__host__ __device__ __forceinline__ void stage_rc(int b, int& R, int& C) { const int st = b / 1024, sb = b % 1024, swz = sb ^ (((sb >> 9) & 1) << 5); R = (st >> 1) * 16 + swz / 64; C = (st & 1) * 32 + (swz % 64) / 2; }
__host__ __device__ __forceinline__ int perm32(int rho) { const int n = rho >> 4, i = rho & 15; return 8 * (i >> 2) + 4 * n + (i & 3); }

struct Unit { int pm, pn; };
struct Gemm { const bf16_t* A; const bf16_t* Bt; int M, N, K; };

struct StaticOrder {
    int nM, nN, nwg, G, c;
    __host__ __device__ void init(int M, int N, int G_, int c_) { nM = M / BM; nN = N / BM; nwg = nM * nN; G = G_; c = c_; }
    __host__ __device__ bool next(int i, Unit& u) const {
        const long L = (long)i * G + c; if (L >= nwg) return false;
        int wgid = (int)L; { const int q = nwg / NXCD, r = nwg % NXCD, xcd = wgid % NXCD, off = wgid / NXCD; wgid = (xcd < r ? xcd * (q + 1) : r * (q + 1) + (xcd - r) * q) + off; }
        const int nig = WGM * nN, gid = wgid / nig, fm = gid * WGM, gsz = (nM - fm) < WGM ? (nM - fm) : WGM;
        u.pm = fm + ((wgid % nig) % gsz); u.pn = (wgid % nig) / gsz; return true;
    }
    __device__ __forceinline__ void a_ready(const Unit&) const {}
    __device__ __forceinline__ void done(const Unit&) const {}
};

__device__ __forceinline__ unsigned cvt_pk_bf16(float lo, float hi) { unsigned r; asm volatile("v_cvt_pk_bf16_f32 %0, %1, %2" : "=v"(r) : "v"(lo), "v"(hi)); return r; }
typedef float f32x2 __attribute__((ext_vector_type(2)));
__device__ __forceinline__ f32x2 gelu_pk(f32x2 v) {
    const f32x2 av = __builtin_elementwise_abs(v), d = av * 0.2316418882f + 1.0f;
    f32x2 t; t.x = __builtin_amdgcn_rcpf(d.x); t.y = __builtin_amdgcn_rcpf(d.y);
    f32x2 q = t * 0.5307027145f + (-0.7265760135f); q = q * t + 0.7107068705f; q = q * t + (-0.142248368f); q = q * t + 0.127414796f; q = q * t;
    const f32x2 s = (v * v) * (-0.72134752044f);
    f32x2 e; e.x = __builtin_amdgcn_exp2f(s.x); e.y = __builtin_amdgcn_exp2f(s.y);
    const f32x2 m = v * (q * e), r = v - m;
    f32x2 o; o.x = v.x < 0.f ? m.x : r.x; o.y = v.y < 0.f ? m.y : r.y; return o;
}

template <int ACT  > struct EpiBf16 {
    static constexpr bool PERM = true, AFTER_DRAIN = false; static_assert(ACT == 0 || ACT == 1, "EpiBf16: ACT is 0 (none) or 1 (gelu_pk)");
    bf16_t* O; int ldc; const float* bias; int split_cols; size_t split_stride; float scale0;
    __device__ __forceinline__ void operator()(const f32x4 (&acc)[2][2][4][2], const Unit& u, int wr, int wc, int fr, int fq) const {
        const int row0 = u.pm * BM + wr * 64 + fr; int colt = u.pn * BM; bf16_t* base = O;
        float sc = 1.f; if (split_cols) { const int t = colt / split_cols; base += (size_t)t * split_stride; colt -= t * split_cols; if (t == 0) sc = scale0; }
        const int col0 = colt + wc * 32 + 8 * fq, bcol0 = u.pn * BM + wc * 32 + 8 * fq;
        f32x4 bv[2][2];
#pragma unroll
        for (int bj = 0; bj < 2; ++bj)
#pragma unroll
            for (int n = 0; n < 2; ++n) bv[bj][n] = bias ? *(const f32x4*)(bias + bcol0 + bj * HALF + 4 * n) : (f32x4){0.f, 0.f, 0.f, 0.f};
#pragma unroll
        for (int ai = 0; ai < 2; ++ai)
#pragma unroll
            for (int m = 0; m < 4; ++m) { bf16_t* rowp = base + (size_t)(row0 + ai * HALF + m * 16) * ldc + col0;
#pragma unroll
                for (int bj = 0; bj < 2; ++bj) { f32x4 v0 = acc[ai][bj][m][0] + bv[bj][0], v1 = acc[ai][bj][m][1] + bv[bj][1];
                    if (ACT == 1) { f32x2 a = gelu_pk((f32x2){v0[0], v0[1]}), b = gelu_pk((f32x2){v0[2], v0[3]}), c = gelu_pk((f32x2){v1[0], v1[1]}), d = gelu_pk((f32x2){v1[2], v1[3]});
                        v0 = (f32x4){a.x, a.y, b.x, b.y}; v1 = (f32x4){c.x, c.y, d.x, d.y}; }
                    v0 = v0 * sc; v1 = v1 * sc; u32x4 w; w.x = cvt_pk_bf16(v0[0], v0[1]); w.y = cvt_pk_bf16(v0[2], v0[3]); w.z = cvt_pk_bf16(v1[0], v1[1]); w.w = cvt_pk_bf16(v1[2], v1[3]);
                    *(u32x4*)(rowp + bj * HALF) = w; } }
    }
};
template <class Epi, class Sched, bool ALIGN_EPI = false, bool SP2 = false>
__device__ __forceinline__ void gemm_phase(PG8_LAS unsigned char* lds, const Gemm g, const Sched& S, const Epi& E) {
    const int tid = threadIdx.x, wid = __builtin_amdgcn_readfirstlane(tid >> 6), lane = tid & 63, wr = wid >> 2, wc = wid & 3, fr = lane & 15, fq = lane >> 4;
    const int K = g.K, nt = K / BK;
    unsigned voffA[2], voffB[2];
#pragma unroll
    for (int i = 0; i < 2; ++i) { int R, C; stage_rc(tid * 16 + i * 8192, R, C); const int Rb = Epi::PERM ? ((R & ~31) + perm32(R & 31)) : R;
        voffA[i] = (unsigned)(R * K + C) * 2u; voffB[i] = (unsigned)(Rb * K + C) * 2u; }
    const size_t kstep = (size_t)(BK * 2);
    const size_t hstep = (size_t)HALF * K * 2;
    const size_t tstep = 2 * hstep;
    const unsigned ldsw = (unsigned)wid * 1024u;
    const int aoff = lds_byte(wr * 64 + fr, fq * 8), boff = lds_byte(wc * 32 + fr, fq * 8);
#define PG8_SA(b, h) (((b) * 2 + (h)) * HTB)
#define PG8_SB(b, h) ((4 + (b) * 2 + (h)) * HTB)
#define PG8_STAGE(bufoff, gbase, voff) do { _Pragma("unroll") for (int _i = 0; _i < 2; ++_i) \
        __builtin_amdgcn_global_load_lds((const unsigned*)((const char*)(gbase) + (voff)[_i]), (PG8_LAS unsigned*)(lds + (bufoff) + ldsw + _i * 8192), 16, 0, 0); } while (0)
#define PG8_LDA(dst, b, h) do { _Pragma("unroll") for (int m = 0; m < 4; ++m) _Pragma("unroll") for (int k = 0; k < 2; ++k) dst[m][k] = *(const PG8_LAS bf16x8*)(lds + PG8_SA(b, h) + aoff + m * 2048 + k * 1024); } while (0)
#define PG8_LDB(dst, b, h) do { _Pragma("unroll") for (int n = 0; n < 2; ++n) _Pragma("unroll") for (int k = 0; k < 2; ++k) dst[n][k] = *(const PG8_LAS bf16x8*)(lds + PG8_SB(b, h) + boff + n * 2048 + k * 1024); } while (0)
#define PG8_MMA(ai, bj, At, Bt) do { __builtin_amdgcn_s_setprio(1); _Pragma("unroll") for (int m = 0; m < 4; ++m) _Pragma("unroll") for (int n = 0; n < 2; ++n) _Pragma("unroll") for (int k = 0; k < 2; ++k) \
        acc[ai][bj][m][n] = __builtin_amdgcn_mfma_f32_16x16x32_bf16(Bt[n][k], At[m][k], acc[ai][bj][m][n], 0, 0, 0); __builtin_amdgcn_s_setprio(0); } while (0)
#define PG8_WAIT_V(n) asm volatile("s_waitcnt vmcnt(" #n ")" ::: "memory")
#define PG8_WAIT_L(n) asm volatile("s_waitcnt lgkmcnt(" #n ")" ::: "memory")
#define PG8_BAR __builtin_amdgcn_s_barrier()
#define PG8_SCHED __builtin_amdgcn_sched_barrier(0)
    Unit cur, nxt; int ui = 0;
    if (!S.next(0, cur)) return;
    f32x4 acc[2][2][4][2];
#pragma unroll
    for (int a = 0; a < 2; ++a)
#pragma unroll
        for (int b = 0; b < 2; ++b)
#pragma unroll
            for (int m = 0; m < 4; ++m)
#pragma unroll
                for (int n = 0; n < 2; ++n) acc[a][b][m][n] = (f32x4){0.f, 0.f, 0.f, 0.f};
    bf16x8 At[4][2], B0[2][2], B1[2][2];
    const char* cA = (const char*)g.A + (size_t)cur.pm * tstep; const char* cB = (const char*)g.Bt + (size_t)cur.pn * tstep;
    S.a_ready(cur);
    if constexpr (SP2) {
        PG8_STAGE(PG8_SB(0, 0), cB, voffB); PG8_STAGE(PG8_SB(0, 1), cB + hstep, voffB); PG8_STAGE(PG8_SA(0, 0), cA, voffA); PG8_STAGE(PG8_SA(0, 1), cA + hstep, voffA);
        if (wr == 1) PG8_BAR;
        PG8_WAIT_V(2); PG8_BAR;
        PG8_STAGE(PG8_SB(1, 0), cB + kstep, voffB); PG8_STAGE(PG8_SA(1, 0), cA + kstep, voffA); PG8_STAGE(PG8_SB(1, 1), cB + hstep + kstep, voffB);
        PG8_WAIT_V(6); PG8_BAR;
    } else {
        PG8_STAGE(PG8_SB(0, 0), cB, voffB); PG8_STAGE(PG8_SA(0, 0), cA, voffA); PG8_STAGE(PG8_SB(0, 1), cB + hstep, voffB); PG8_STAGE(PG8_SA(0, 1), cA + hstep, voffA);
        if (wr == 1) PG8_BAR;
        PG8_WAIT_V(4); PG8_BAR;
        PG8_STAGE(PG8_SB(1, 0), cB + kstep, voffB); PG8_STAGE(PG8_SA(1, 0), cA + kstep, voffA); PG8_STAGE(PG8_SB(1, 1), cB + hstep + kstep, voffB);
        PG8_WAIT_V(6); PG8_BAR;
    }
    for (;;) {
        const bool has_next = S.next(ui + 1, nxt);
        const char* nA = has_next ? (const char*)g.A + (size_t)nxt.pm * tstep : cA; const char* nB = has_next ? (const char*)g.Bt + (size_t)nxt.pn * tstep : cB;
        for (int t = 0; t < nt; t += 2) {
            const bool last = (t == nt - 2);
            const char* a1 = cA + (size_t)(t + 1) * kstep;
            const char* a2 = last ? nA : cA + (size_t)(t + 2) * kstep; const char* b2 = last ? nB : cB + (size_t)(t + 2) * kstep;
            const char* a3 = a2 + kstep; const char* b3 = b2 + kstep;
            if (last && has_next) S.a_ready(nxt);
            if constexpr (SP2) {
            PG8_LDB(B0, 0, 0); PG8_LDB(B1, 0, 1); PG8_SCHED; PG8_LDA(At, 0, 0); PG8_STAGE(PG8_SA(1, 1), a1 + hstep, voffA);
            PG8_WAIT_V(8); PG8_WAIT_L(0); PG8_BAR; PG8_MMA(0, 0, At, B0); PG8_MMA(0, 1, At, B1); PG8_BAR; PG8_SCHED;
            PG8_LDA(At, 0, 1); PG8_STAGE(PG8_SB(0, 0), b2, voffB); PG8_STAGE(PG8_SB(0, 1), b2 + hstep, voffB); PG8_STAGE(PG8_SA(0, 0), a2, voffA);
            PG8_WAIT_V(8); PG8_WAIT_L(0); PG8_BAR; PG8_MMA(1, 0, At, B0); PG8_MMA(1, 1, At, B1); PG8_BAR; PG8_SCHED;
            PG8_LDB(B0, 1, 0); PG8_LDB(B1, 1, 1); PG8_SCHED; PG8_LDA(At, 1, 0); PG8_STAGE(PG8_SA(0, 1), a2 + hstep, voffA);
            PG8_WAIT_V(8); PG8_WAIT_L(0); PG8_BAR; PG8_MMA(0, 0, At, B0); PG8_MMA(0, 1, At, B1); PG8_BAR; PG8_SCHED;
            PG8_LDA(At, 1, 1); PG8_STAGE(PG8_SB(1, 0), b3, voffB); PG8_STAGE(PG8_SB(1, 1), b3 + hstep, voffB); PG8_STAGE(PG8_SA(1, 0), a3, voffA);
            PG8_WAIT_V(8); PG8_WAIT_L(0); PG8_BAR; PG8_MMA(1, 0, At, B0); PG8_MMA(1, 1, At, B1); PG8_BAR; PG8_SCHED;
            } else {
            PG8_LDB(B0, 0, 0); PG8_SCHED; PG8_LDA(At, 0, 0); PG8_STAGE(PG8_SA(1, 1), a1 + hstep, voffA);
            PG8_WAIT_L(8); PG8_BAR; PG8_WAIT_L(0); PG8_MMA(0, 0, At, B0); PG8_BAR; PG8_SCHED;
            PG8_LDB(B1, 0, 1); PG8_STAGE(PG8_SB(0, 0), b2, voffB);
            PG8_BAR; PG8_WAIT_L(0); PG8_MMA(0, 1, At, B1); PG8_BAR;
            PG8_LDA(At, 0, 1); PG8_STAGE(PG8_SA(0, 0), a2, voffA);
            PG8_BAR; PG8_WAIT_L(0); PG8_MMA(1, 0, At, B0); PG8_BAR; PG8_SCHED;
            PG8_STAGE(PG8_SB(0, 1), b2 + hstep, voffB);
            PG8_WAIT_V(6); PG8_BAR; PG8_MMA(1, 1, At, B1); PG8_BAR;
            PG8_LDB(B0, 1, 0); PG8_SCHED; PG8_LDA(At, 1, 0); PG8_STAGE(PG8_SA(0, 1), a2 + hstep, voffA);
            PG8_WAIT_L(8); PG8_BAR; PG8_WAIT_L(0); PG8_MMA(0, 0, At, B0); PG8_BAR; PG8_SCHED;
            PG8_LDB(B1, 1, 1); PG8_STAGE(PG8_SB(1, 0), b3, voffB);
            PG8_BAR; PG8_WAIT_L(0); PG8_MMA(0, 1, At, B1); PG8_BAR;
            PG8_LDA(At, 1, 1); PG8_STAGE(PG8_SA(1, 0), a3, voffA);
            PG8_BAR; PG8_WAIT_L(0); PG8_MMA(1, 0, At, B0); PG8_BAR; PG8_SCHED;
            PG8_STAGE(PG8_SB(1, 1), b3 + hstep, voffB);
            PG8_WAIT_V(6); PG8_BAR; PG8_MMA(1, 1, At, B1); PG8_BAR;
            }
        }
        if constexpr (ALIGN_EPI) { if (wr == 0) PG8_BAR; }
        if constexpr (!Epi::AFTER_DRAIN) { E(acc, cur, wr, wc, fr, fq); S.done(cur); }
        if (!has_next) break;
#pragma unroll
        for (int a = 0; a < 2; ++a)
#pragma unroll
            for (int b = 0; b < 2; ++b)
#pragma unroll
                for (int m = 0; m < 4; ++m)
#pragma unroll
                    for (int n = 0; n < 2; ++n) acc[a][b][m][n] = (f32x4){0.f, 0.f, 0.f, 0.f};
        cur = nxt; cA = nA; cB = nB; ++ui;
        if constexpr (ALIGN_EPI) { if (wr == 1) PG8_BAR; }
    }
    PG8_WAIT_V(0);
    if constexpr (!ALIGN_EPI) { if (wr == 0) PG8_BAR; }
    PG8_BAR;
    if constexpr (Epi::AFTER_DRAIN) { E.fused(acc, cur, wr, wc, fr, fq, lds, wid, lane); S.done(cur); }
#undef PG8_SA
#undef PG8_SB
#undef PG8_STAGE
#undef PG8_LDA
#undef PG8_LDB
#undef PG8_MMA
#undef PG8_WAIT_V
#undef PG8_WAIT_L
#undef PG8_BAR
#undef PG8_SCHED
}
}
#define PG8_SP2 true
#define PG8_ALIGN true

namespace pg8 {
template <int ACT  > struct EpiBf16Act {
    static constexpr bool PERM = true, AFTER_DRAIN = false;
    bf16_t* O; int ldc;
    __device__ __forceinline__ void operator()(const f32x4 (&acc)[2][2][4][2], const Unit& u, int wr, int wc, int fr, int fq) const {
        const int row0 = u.pm * BM + wr * 64 + fr; const int col0 = u.pn * BM + wc * 32 + 8 * fq;
#pragma unroll
        for (int ai = 0; ai < 2; ++ai)
#pragma unroll
            for (int m = 0; m < 4; ++m) { bf16_t* rowp = O + (size_t)(row0 + ai * HALF + m * 16) * ldc + col0;
#pragma unroll
                for (int bj = 0; bj < 2; ++bj) { f32x4 v0 = acc[ai][bj][m][0], v1 = acc[ai][bj][m][1];
                    if (ACT == 2) {
#pragma unroll
                        for (int e = 0; e < 4; ++e) { const float a = fmaxf(v0[e], 0.f), b = fmaxf(v1[e], 0.f); v0[e] = a * a; v1[e] = b * b; } }
                    u32x4 w; w.x = cvt_pk_bf16(v0[0], v0[1]); w.y = cvt_pk_bf16(v0[2], v0[3]); w.z = cvt_pk_bf16(v1[0], v1[1]); w.w = cvt_pk_bf16(v1[2], v1[3]);
                    *(u32x4*)(rowp + bj * HALF) = w; } }
    }
};
struct EpiResF32 {
    static constexpr bool PERM = false, AFTER_DRAIN = false;
    const float* base; float* out; int ldc;
    __device__ __forceinline__ void operator()(const f32x4 (&acc)[2][2][4][2], const Unit& u, int wr, int wc, int fr, int fq) const {
        const int col0 = u.pn * BM + wc * 32 + 4 * fq;
#pragma unroll
        for (int ai = 0; ai < 2; ++ai)
#pragma unroll
            for (int m = 0; m < 4; ++m) { const int r = ai * HALF + wr * 64 + m * 16 + fr; const size_t off = (size_t)(u.pm * BM + r) * ldc + col0;
#pragma unroll
                for (int bj = 0; bj < 2; ++bj)
#pragma unroll
                    for (int n = 0; n < 2; ++n) { const f32x4 bs = *(const f32x4*)(base + off + bj * HALF + n * 16); *(f32x4*)(out + off + bj * HALF + n * 16) = bs + acc[ai][bj][m][n]; } }
    }
};
}

namespace pg8 {
template <int REPN> struct RepOrder {
    StaticOrder b;
    __host__ __device__ void init(int M, int N, int G_, int c_) { b.init(M, N, G_, c_); }
    __host__ __device__ bool next(int i, Unit& u) const { return b.next(i / REPN, u); }
    __device__ __forceinline__ void a_ready(const Unit&) const {}
    __device__ __forceinline__ void done(const Unit&) const {}
};
}
constexpr int BATCH = 2, SEQ = 16384, DM = 2048, M = BATCH * SEQ;
constexpr int POOLW = 1024, ATTW = 1024, NHEAD = 8, HD = 128, INW = 4096, DFF = 8192;
constexpr int PP = INW + 136;
constexpr float EPS = 1e-6f;
constexpr float QSCALE = 0.08838834764831845f * 1.4426950408889634f;
constexpr float LOG2E = 1.4426950408889634f;
constexpr int NWAVES = 8, NTHREADS = 512;

constexpr size_t MiB = 1u << 20;
constexpr size_t WS_BAR = 16384;
constexpr size_t WS_WCAT = 2 * MiB;
constexpr size_t WS_WOUT = 18 * MiB;
constexpr size_t WS_WUP = 26 * MiB;
constexpr size_t WS_WDN = 58 * MiB;
constexpr size_t WS_XN = 96 * MiB;
constexpr size_t WS_PROJ = 224 * MiB;
constexpr size_t WS_CAT = 496 * MiB;
constexpr size_t WS_OPART = 624 * MiB;
constexpr size_t WS_ML = 816 * MiB;
constexpr size_t WS_H = 224 * MiB;
constexpr size_t WS_END = 822 * MiB;
static_assert(WS_PROJ + (size_t)M * PP * 2 <= WS_CAT, "proj fits");

constexpr int RING_BYTES = 131072;
constexpr int LDS_BYTES = 147456;

#define LAS __attribute__((address_space(3)))
typedef unsigned short bf16;
typedef unsigned v4u __attribute__((ext_vector_type(4)));
typedef unsigned v2u __attribute__((ext_vector_type(2)));
typedef float f32x4 __attribute__((ext_vector_type(4)));
typedef float f32x2 __attribute__((ext_vector_type(2)));
typedef float f32x16 __attribute__((ext_vector_type(16)));
typedef short bf16x8 __attribute__((ext_vector_type(8)));
typedef short s16x4 __attribute__((ext_vector_type(4)));

__device__ __forceinline__ unsigned f2bf(float f) { unsigned u = __builtin_bit_cast(unsigned, f); return (u + 0x7fffu + ((u >> 16) & 1u)) >> 16; }
__device__ __forceinline__ unsigned pk2(float lo, float hi) { return f2bf(lo) | (f2bf(hi) << 16); }
__device__ __forceinline__ float bflo(unsigned w) { return __builtin_bit_cast(float, w << 16); }
__device__ __forceinline__ float bfhi(unsigned w) { return __builtin_bit_cast(float, w & 0xffff0000u); }
__device__ __forceinline__ float wave_sum(float v) {
#pragma unroll
    for (int o = 1; o < 64; o <<= 1) v += __shfl_xor(v, o);
    return v;
}

__device__ __forceinline__ void p0_transpose_item(const float* W, int ldw, int K, int N, bf16* WT, int row_off, int nscale, float sc, LAS float* scr, int item, int lane) {
    const int nblk = N / 32, kb = item / nblk, nb = item % nblk, k0 = 64 * kb, n0 = 32 * nb;
    const float s = (n0 < nscale) ? sc : 1.0f;
    f32x4 wv[8];
#pragma unroll
    for (int i = 0; i < 8; ++i) wv[i] = *(const f32x4*)(W + (size_t)(k0 + 8 * i + (lane >> 3)) * ldw + n0 + 4 * (lane & 7));
#pragma unroll
    for (int i = 0; i < 8; ++i) { LAS float* d = scr + (8 * i + (lane >> 3)) * 33 + 4 * (lane & 7); d[0] = wv[i].x * s; d[1] = wv[i].y * s; d[2] = wv[i].z * s; d[3] = wv[i].w * s; }
    asm volatile("s_waitcnt lgkmcnt(0)" ::: "memory");
    const int c = lane & 7;
#pragma unroll
    for (int j = 0; j < 4; ++j) { const int n = (lane >> 3) + 8 * j; const LAS float* sp = scr + (8 * c) * 33 + n;
        v4u o; o.x = pk2(sp[0 * 33], sp[1 * 33]); o.y = pk2(sp[2 * 33], sp[3 * 33]); o.z = pk2(sp[4 * 33], sp[5 * 33]); o.w = pk2(sp[6 * 33], sp[7 * 33]);
        *(v4u*)(WT + (size_t)(row_off + n0 + n) * K + k0 + 8 * c) = o; }
    asm volatile("s_waitcnt lgkmcnt(0)" ::: "memory");
}
template <bool BF> __device__ __forceinline__ void rms_row(const float* xrow, const float* g, void* orow, int lane) {
    const f32x4* xr = (const f32x4*)xrow + lane; const f32x4* gr = (const f32x4*)g + lane;
    f32x4 v[8]; float s = 0.f;
#pragma unroll
    for (int j = 0; j < 8; ++j) { v[j] = xr[64 * j]; s += (v[j].x * v[j].x + v[j].y * v[j].y) + (v[j].z * v[j].z + v[j].w * v[j].w); }
    const float rstd = 1.0f / sqrtf(wave_sum(s) * (1.0f / DM) + EPS);
#pragma unroll
    for (int j = 0; j < 8; ++j) { const f32x4 gg = gr[64 * j]; const f32x4 o = v[j] * rstd * gg;
        if (BF) { v2u w; w.x = pk2(o.x, o.y); w.y = pk2(o.z, o.w); ((v2u*)orow)[64 * j + lane] = w; }
        else ((f32x4*)orow)[64 * j + lane] = o; }
}

constexpr int TILE_B = 8192;
constexpr int WAVE_LDS = 2 * TILE_B;
__device__ __forceinline__ int crow(int r, int hi) { return (r & 3) + 8 * (r >> 2) + 4 * hi; }
__device__ __forceinline__ int swz16(int row) { return ((row & 3) << 2) | ((row >> 2) & 3); }
__device__ __forceinline__ s16x4 vtr(const LAS char* p) { typedef short v4i16_t __attribute__((ext_vector_type(4))); return __builtin_bit_cast(s16x4, __builtin_amdgcn_ds_read_tr16_b64_v4i16((LAS v4i16_t*)p)); }
__device__ __forceinline__ unsigned cvtpk(float lo, float hi) { unsigned r; asm("v_cvt_pk_bf16_f32 %0, %1, %2" : "=v"(r) : "v"(lo), "v"(hi)); return r; }

constexpr int ATT_P = 3, ATT_R = 4, ATT_STEPS = 36, SLOT_B = 2 * TILE_B, OST_OFF = ATT_R * SLOT_B;
__device__ __forceinline__ void attn_wg_unit(const bf16* __restrict__ proj, bf16* __restrict__ opart, f32x2* __restrict__ ml, int wgu, LAS char* lds, int wave, int lane, const int pv) {
    const int p = wgu >> 8, rem = wgu & 255, bh = rem >> 4, b = bh >> 3, h = bh & 7, blk0 = (rem & 15) * 32;
    const int ls = 2 * p, r = blk0 >> (9 - ls), ib0 = blk0 & ((512 >> ls) - 1);
    const int q = lane & 31, hi = lane >> 5;
    const size_t rowbase = (size_t)b * SEQ + r;
    const float sl = __builtin_amdgcn_exp2f(-(float)(h + 1)) * LOG2E * (float)(1 << ls);
    const float b4 = sl * (float)(4 * hi);
    LAS char* ost = lds + OST_OFF + wave * TILE_B;
    const int lr = lane >> 4, c0 = (lane & 15) ^ (lr << 2);
    const int swzq = swz16(q);
    const int kb = q * 256 + 16 * (hi ^ swzq);
    const int qq = (lane & 15) >> 2, pp = lane & 3, bk = (lane >> 4) & 1;
    const int vb = TILE_B + (4 * hi + qq) * 256 + 8 * (pp & 1) + 16 * ((2 * bk + (pp >> 1)) ^ hi ^ (qq << 2));
    const int ob = q * 256 + 8 * hi + 16 * swzq;
    const size_t rstep = ((size_t)PP * 2) << ls;
    const char* KVu = (const char*)(proj + rowbase * PP + POOLW + ATTW + h * HD) + (size_t)(4 * wave) * rstep;
    const unsigned voff = (unsigned)((((size_t)lr << ls) * PP + (c0 ^ (wave & 3)) * 8) * 2);
    const int kbmax = (512 >> ls) - 1;
#define ATT_DMA(t_) do { int kbi_ = ib0 - 4 + (t_); kbi_ = kbi_ < 0 ? 0 : (kbi_ > kbmax ? kbmax : kbi_); if (pv == 3) kbi_ = 0; const char* ub_ = KVu + (size_t)(kbi_ * 32) * rstep + voff; \
        LAS char* sl_ = lds + ((t_) & (ATT_R - 1)) * SLOT_B + wave * 1024; \
        __builtin_amdgcn_global_load_lds((const unsigned*)ub_, (LAS unsigned*)sl_, 16, 0, 0); \
        __builtin_amdgcn_global_load_lds((const unsigned*)(ub_ + ATTW * 2), (LAS unsigned*)(sl_ + TILE_B), 16, 0, 0); } while (0)
    const char* Qu = (const char*)(proj + rowbase * PP + POOLW + h * HD);
    unsigned voffq[4];
#pragma unroll
    for (int x = 0; x < 4; ++x) voffq[x] = (unsigned)((((size_t)lr << ls) * PP + (c0 ^ x) * 8) * 2);
#define ATT_QDMA(j_) do { const char* uq_ = Qu + (size_t)((ib0 + (j_)) * 32) * rstep; _Pragma("unroll") for (int jj_ = 0; jj_ < 8; ++jj_) \
        __builtin_amdgcn_global_load_lds((const unsigned*)(uq_ + (size_t)(4 * jj_) * rstep + voffq[jj_ & 3]), (LAS unsigned*)(ost + jj_ * 1024), 16, 0, 0); } while (0)
    asm volatile("s_waitcnt lgkmcnt(0)" ::: "memory");
    __builtin_amdgcn_s_barrier();
    asm volatile("" ::: "memory");
    int jcur = wave;
    ATT_QDMA(jcur);
    ATT_DMA(0); ATT_DMA(1); ATT_DMA(2);
    bf16x8 qf[8];
#pragma unroll
    for (int s = 0; s < 8; ++s) qf[s] = (bf16x8){0, 0, 0, 0, 0, 0, 0, 0};
    float m = -1e30f, l = 0.f;
    f32x16 o[4];
#pragma unroll
    for (int c = 0; c < 4; ++c)
#pragma unroll
        for (int e = 0; e < 16; ++e) o[c][e] = 0.f;
    for (int t = 0; t < ATT_STEPS; ++t) {
        asm volatile("s_waitcnt vmcnt(4)" ::: "memory");
        __builtin_amdgcn_s_barrier();
        asm volatile("" ::: "memory");
        ATT_DMA(t + ATT_P);
        const int kt = t - jcur;
        if (kt >= 0 && kt <= 4) {
            if (ib0 - 4 + t >= 0 && pv != 4) {
                const LAS char* slot = lds + (t & (ATT_R - 1)) * SLOT_B;
                if (kt == 0 || t == 4 - ib0) {
#pragma unroll
                    for (int ss = 0; ss < 8; ++ss) qf[ss] = *(const LAS bf16x8*)(ost + (kb ^ (32 * ss)));
                }
                bf16x8 kf[8];
#pragma unroll
                for (int ss = 0; ss < 8; ++ss) kf[ss] = *(const LAS bf16x8*)(slot + (kb ^ (32 * ss)));
                f32x16 s;
#pragma unroll
                for (int e = 0; e < 16; ++e) s[e] = 0.f;
#pragma unroll
                for (int ss = 0; ss < 8; ++ss) s = __builtin_amdgcn_mfma_f32_32x32x16_bf16(kf[ss], qf[ss], s, 0, 0, 0);
                const int dbase = q + 128 - 32 * kt;
                float mx = -INFINITY;
                if (kt == 0 || kt == 4) {
#pragma unroll
                    for (int e = 0; e < 16; ++e) { const int dl = dbase - crow(e, hi); float v = __builtin_fmaf(sl, (float)((e & 3) + 8 * (e >> 2)), s[e]); v = (dl < 0 || dl > 128) ? -INFINITY : v; s[e] = v; mx = fmaxf(mx, v); }
                } else {
#pragma unroll
                    for (int e = 0; e < 16; ++e) { const float v = __builtin_fmaf(sl, (float)((e & 3) + 8 * (e >> 2)), s[e]); s[e] = v; mx = fmaxf(mx, v); }
                }
                mx += b4;
                mx = fmaxf(mx, __shfl_xor(mx, 32));
                const float sd = sl * (float)dbase;
                const float mn = fmaxf(m, mx - sd), alpha = __builtin_amdgcn_exp2f(m - mn);
                m = mn;
                const float sh = mn + sd - b4;
                float ps = 0.f;
#pragma unroll
                for (int e = 0; e < 16; ++e) { s[e] = __builtin_amdgcn_exp2f(s[e] - sh); ps += s[e]; }
                l = l * alpha + ps;
#pragma unroll
                for (int c = 0; c < 4; ++c)
#pragma unroll
                    for (int e = 0; e < 16; ++e) o[c][e] *= alpha;
                v4u pw0, pw1;
                pw0.x = cvtpk(s[0], s[1]); pw0.y = cvtpk(s[2], s[3]); pw0.z = cvtpk(s[4], s[5]); pw0.w = cvtpk(s[6], s[7]);
                pw1.x = cvtpk(s[8], s[9]); pw1.y = cvtpk(s[10], s[11]); pw1.z = cvtpk(s[12], s[13]); pw1.w = cvtpk(s[14], s[15]);
                const bf16x8 pf0 = __builtin_bit_cast(bf16x8, pw0), pf1 = __builtin_bit_cast(bf16x8, pw1);
#pragma unroll
                for (int ch = 0; ch < 2; ++ch) {
                    s16x4 vr[2][4];
#pragma unroll
                    for (int c2 = 0; c2 < 2; ++c2)
#pragma unroll
                        for (int kk = 0; kk < 4; ++kk) vr[c2][kk] = vtr(slot + ((vb ^ (16 * ((4 * (2 * ch + c2)) ^ (2 * (kk & 1))))) + 2048 * kk));
#pragma unroll
                    for (int c2 = 0; c2 < 2; ++c2) { const int c = 2 * ch + c2;
                        const bf16x8 vf0 = (bf16x8){vr[c2][0][0], vr[c2][0][1], vr[c2][0][2], vr[c2][0][3], vr[c2][1][0], vr[c2][1][1], vr[c2][1][2], vr[c2][1][3]};
                        const bf16x8 vf1 = (bf16x8){vr[c2][2][0], vr[c2][2][1], vr[c2][2][2], vr[c2][2][3], vr[c2][3][0], vr[c2][3][1], vr[c2][3][2], vr[c2][3][3]};
                        o[c] = __builtin_amdgcn_mfma_f32_32x32x16_bf16(vf0, pf0, o[c], 0, 0, 0);
                        o[c] = __builtin_amdgcn_mfma_f32_32x32x16_bf16(vf1, pf1, o[c], 0, 0, 0); }
                }
                asm volatile("s_waitcnt lgkmcnt(0)" ::: "memory");
            }
            if (kt == 4) {
                const float lt = l + __shfl_xor(l, 32), inv = 1.0f / lt;
                const size_t qrow = rowbase + ((size_t)((ib0 + jcur) * 32 + q) << ls);
#pragma unroll
                for (int c = 0; c < 4; ++c)
#pragma unroll
                    for (int g4 = 0; g4 < 4; ++g4) { v2u w; w.x = cvtpk(o[c][4 * g4] * inv, o[c][4 * g4 + 1] * inv); w.y = cvtpk(o[c][4 * g4 + 2] * inv, o[c][4 * g4 + 3] * inv);
                        *(LAS v2u*)(ost + (ob ^ (16 * (4 * c + g4)))) = w; }
                asm volatile("s_waitcnt lgkmcnt(0)" ::: "memory");
                bf16* Ob = opart + ((size_t)p * M + rowbase) * ATTW + h * HD;
                if (pv == 0)
#pragma unroll
                for (int j = 0; j < 8; ++j) { const v4u w = *(const LAS v4u*)(ost + j * 1024 + lane * 16);
                    *(v4u*)(Ob + ((size_t)((ib0 + jcur) * 32 + 4 * j + lr) << ls) * ATTW + (c0 ^ (j & 3)) * 8) = w; }
                if (hi == 0 && pv == 0) ml[((size_t)p * M + qrow) * NHEAD + h] = (f32x2){m, lt};
                asm volatile("s_waitcnt lgkmcnt(0)" ::: "memory");
                jcur += 8;
                if (jcur < 32) ATT_QDMA(jcur);
                m = -1e30f; l = 0.f;
#pragma unroll
                for (int c = 0; c < 4; ++c)
#pragma unroll
                    for (int e = 0; e < 16; ++e) o[c][e] = 0.f;
            }
        }
    }
#undef ATT_DMA
#undef ATT_QDMA
}

__device__ __forceinline__ void merge_row(const bf16* __restrict__ proj, const bf16* __restrict__ opart, const f32x2* __restrict__ ml, const float* __restrict__ gp, const float* __restrict__ ga,
                                          bf16* __restrict__ cat, int row, int lane) {
    const int t = row & (SEQ - 1), c0 = lane * 16;
    float y[16];
    {
        const int w = 2 << (lane >> 4), cnt = (t + 1 < w) ? t + 1 : w;
        float acc[16];
#pragma unroll
        for (int j = 0; j < 16; ++j) acc[j] = 0.f;
#pragma unroll
        for (int hb = 0; hb < 2; ++hb) {
            v4u za[8], zb[8];
#pragma unroll
            for (int i = 0; i < 8; ++i) { const int ii = 8 * hb + i; const v4u* zp = (const v4u*)(proj + (size_t)(row - (ii < cnt ? ii : 0)) * PP + c0); za[i] = zp[0]; zb[i] = zp[1]; }
#pragma unroll
            for (int i = 0; i < 8; ++i) {
                const int ii = 8 * hb + i; const v4u a = za[i], b = zb[i]; const float mk = (ii == 0) ? -(float)(cnt - 1) : ((ii < cnt) ? 1.0f : 0.0f);
                float f[16] = {bflo(a.x), bfhi(a.x), bflo(a.y), bfhi(a.y), bflo(a.z), bfhi(a.z), bflo(a.w), bfhi(a.w), bflo(b.x), bfhi(b.x), bflo(b.y), bfhi(b.y), bflo(b.z), bfhi(b.z), bflo(b.w), bfhi(b.w)};
#pragma unroll
                for (int j = 0; j < 16; ++j) acc[j] += mk * f[j];
            }
        }
        const float ic = 1.0f / (float)cnt;
#pragma unroll
        for (int j = 0; j < 16; ++j) y[j] = acc[j] * ic;
    }
    {
        float ss = 0.f;
#pragma unroll
        for (int j = 0; j < 16; ++j) ss += y[j] * y[j];
        const float rstd = 1.0f / sqrtf(wave_sum(ss) * (1.0f / POOLW) + EPS);
        const f32x4* g4 = (const f32x4*)(gp + c0);
        v4u o0, o1; const f32x4 ga0 = g4[0], ga1 = g4[1], ga2 = g4[2], ga3 = g4[3];
        o0.x = pk2(y[0] * rstd * ga0.x, y[1] * rstd * ga0.y); o0.y = pk2(y[2] * rstd * ga0.z, y[3] * rstd * ga0.w);
        o0.z = pk2(y[4] * rstd * ga1.x, y[5] * rstd * ga1.y); o0.w = pk2(y[6] * rstd * ga1.z, y[7] * rstd * ga1.w);
        o1.x = pk2(y[8] * rstd * ga2.x, y[9] * rstd * ga2.y); o1.y = pk2(y[10] * rstd * ga2.z, y[11] * rstd * ga2.w);
        o1.z = pk2(y[12] * rstd * ga3.x, y[13] * rstd * ga3.y); o1.w = pk2(y[14] * rstd * ga3.z, y[15] * rstd * ga3.w);
        v4u* cp = (v4u*)(cat + (size_t)row * DM + c0); cp[0] = o0; cp[1] = o1;
    }
    {
        const int hd = lane >> 3;
        const f32x2 s0 = ml[((size_t)0 * M + row) * NHEAD + hd], s1 = ml[((size_t)1 * M + row) * NHEAD + hd], s2 = ml[((size_t)2 * M + row) * NHEAD + hd];
        const float mx = fmaxf(s0.x, fmaxf(s1.x, s2.x));
        float w0 = __builtin_amdgcn_exp2f(s0.x - mx) * s0.y, w1 = __builtin_amdgcn_exp2f(s1.x - mx) * s1.y, w2 = __builtin_amdgcn_exp2f(s2.x - mx) * s2.y;
        const float iw = 1.0f / (w0 + w1 + w2); w0 *= iw; w1 *= iw; w2 *= iw;
#pragma unroll
        for (int j = 0; j < 16; ++j) y[j] = 0.f;
#pragma unroll
        for (int i = 0; i < 3; ++i) {
            const float wi = i == 0 ? w0 : (i == 1 ? w1 : w2);
            const v4u* op = (const v4u*)(opart + ((size_t)i * M + row) * ATTW + c0);
            const v4u a = op[0], b = op[1];
            float f[16] = {bflo(a.x), bfhi(a.x), bflo(a.y), bfhi(a.y), bflo(a.z), bfhi(a.z), bflo(a.w), bfhi(a.w), bflo(b.x), bfhi(b.x), bflo(b.y), bfhi(b.y), bflo(b.z), bfhi(b.z), bflo(b.w), bfhi(b.w)};
#pragma unroll
            for (int j = 0; j < 16; ++j) y[j] += wi * f[j];
        }
        float ss = 0.f;
#pragma unroll
        for (int j = 0; j < 16; ++j) ss += y[j] * y[j];
        const float rstd = 1.0f / sqrtf(wave_sum(ss) * (1.0f / ATTW) + EPS);
        const f32x4* g4 = (const f32x4*)(ga + c0);
        v4u o0, o1; const f32x4 ga0 = g4[0], ga1 = g4[1], ga2 = g4[2], ga3 = g4[3];
        o0.x = pk2(y[0] * rstd * ga0.x, y[1] * rstd * ga0.y); o0.y = pk2(y[2] * rstd * ga0.z, y[3] * rstd * ga0.w);
        o0.z = pk2(y[4] * rstd * ga1.x, y[5] * rstd * ga1.y); o0.w = pk2(y[6] * rstd * ga1.z, y[7] * rstd * ga1.w);
        o1.x = pk2(y[8] * rstd * ga2.x, y[9] * rstd * ga2.y); o1.y = pk2(y[10] * rstd * ga2.z, y[11] * rstd * ga2.w);
        o1.z = pk2(y[12] * rstd * ga3.x, y[13] * rstd * ga3.y); o1.w = pk2(y[14] * rstd * ga3.z, y[15] * rstd * ga3.w);
        v4u* cp = (v4u*)(cat + (size_t)row * DM + POOLW + c0); cp[0] = o0; cp[1] = o1;
    }
}

#define XB_TMO      128
#define XB_XCNT(j)  (256  + 64 * (j))
#define XB_XSUB(j)  (1280 + 64 * (j))
#define XB_XGEN(j)  (2304 + 64 * (j))
#define XB_TOP      3328
#define XB_TOPGEN   3392
#define XCD_BAR_WORDS 3456
#define XB_SPIN_CAP (1u << 18)

__device__ __forceinline__ unsigned xb_ld(unsigned* p)              { return __hip_atomic_load(p, __ATOMIC_RELAXED, __HIP_MEMORY_SCOPE_AGENT); }
__device__ __forceinline__ unsigned xb_add(unsigned* p, unsigned v) { return __hip_atomic_fetch_add(p, v, __ATOMIC_RELAXED, __HIP_MEMORY_SCOPE_AGENT); }
__device__ __forceinline__ unsigned xb_xcc_id() { return (unsigned)__builtin_amdgcn_s_getreg((3 << 11) | 20) & 0xFu; }
#define XB_SPIN(cond, bar) do { unsigned _sp = 0; while (cond) { __builtin_amdgcn_s_sleep(1); \
    if ((++_sp & 255u) == 0u) { if (xb_ld(&(bar)[XB_TMO])) break; if (_sp > XB_SPIN_CAP) { atomicAdd(&(bar)[XB_TMO], 1u); break; } } } } while (0)

struct XcdBarrier {
    unsigned* bar; unsigned x;
    volatile LAS unsigned* st;
};

__device__ __forceinline__ XcdBarrier xcd_barrier_post(unsigned* bar, volatile LAS unsigned* st) {
    XcdBarrier b; b.bar = bar; b.x = xb_xcc_id(); b.st = st;
    if (threadIdx.x == 0) (void)xb_add(&bar[XB_XCNT(b.x)], 1u);
    return b;
}
__device__ __forceinline__ void xcd_barrier_complete(unsigned* bar, unsigned x, unsigned& nloc, unsigned& nx) {
    const unsigned G = gridDim.x * gridDim.y * gridDim.z;
    unsigned sum, cnt, mine, sp = 0u;
    for (;;) {
        sum = 0u; cnt = 0u; mine = 0u;
#pragma unroll
        for (unsigned j = 0; j < 16; ++j) { const unsigned c = xb_ld(&bar[XB_XCNT(j)]); sum += c; cnt += (c > 0u) ? 1u : 0u; mine = (j == x) ? c : mine; }
        if (sum == G) break;
        __builtin_amdgcn_s_sleep(1);
        if ((++sp & 255u) == 0u) { if (xb_ld(&bar[XB_TMO])) break; if (sp > XB_SPIN_CAP) { atomicAdd(&bar[XB_TMO], 1u); break; } }
    }
    nloc = mine > 0u ? mine : 1u; nx = cnt > 0u ? cnt : 1u;
}

__device__ __forceinline__ void xcd_barrier(const XcdBarrier& b) {
    asm volatile("s_waitcnt vmcnt(0)" ::: "memory");
    __syncthreads();
    if (threadIdx.x == 0) {
        unsigned* bar = b.bar;
        __builtin_amdgcn_s_waitcnt(0);
        unsigned nloc = b.st[0], nx = b.st[1];
        if (nloc == 0u) { xcd_barrier_complete(bar, b.x, nloc, nx); b.st[0] = nloc; b.st[1] = nx; }
        const unsigned old = xb_add(&bar[XB_XSUB(b.x)], 1u);
        const unsigned gen = old / nloc;
        if (old + 1u == (gen + 1u) * nloc) {
            __builtin_amdgcn_fence(__ATOMIC_RELEASE, "agent");
            asm volatile("s_waitcnt vmcnt(0)" ::: "memory");
            const unsigned og = xb_add(&bar[XB_TOP], 1u);
            const unsigned tg = og / nx;
            if (og + 1u == (tg + 1u) * nx) xb_add(&bar[XB_TOPGEN], 1u);
            else XB_SPIN(xb_ld(&bar[XB_TOPGEN]) == tg, bar);
            __builtin_amdgcn_fence(__ATOMIC_ACQUIRE, "agent");
            xb_add(&bar[XB_XGEN(b.x)], 1u);
            asm volatile("s_waitcnt vmcnt(0)" ::: "memory");
        } else {
            XB_SPIN(xb_ld(&bar[XB_XGEN(b.x)]) == gen, bar);
            __builtin_amdgcn_fence(__ATOMIC_ACQUIRE, "agent");
            asm volatile("s_waitcnt vmcnt(0)" ::: "memory");
        }
    }
    __syncthreads();
}

#ifndef MK_N_LAUNCHES
#define MK_N_LAUNCHES 1
#endif
constexpr int N_PHASES = 9;
#ifndef PROBE_SYNC
#define PROBE_SYNC 0
#endif
#ifndef PROBE_GEMM
#define PROBE_GEMM -1
#endif
#ifndef PROBE_VAR
#define PROBE_VAR 0
#endif
#ifndef PROBE_REP
#define PROBE_REP -1
#endif
#define REP(k) for (int rep_ = 0; rep_ < ((PROBE_REP) == (k) ? 2 : 1); ++rep_)
struct Args { const float* in[12]; float* out; unsigned char* ws; int ph_lo, ph_hi; };

__global__ void __launch_bounds__(NTHREADS, 2) fwd_mega(Args args) {
    extern __shared__ __attribute__((aligned(16))) unsigned char lds_raw[];
    LAS unsigned char* lds = (LAS unsigned char*)lds_raw;
    const int tid = threadIdx.x, lane = tid & 63, wave = __builtin_amdgcn_readfirstlane(tid >> 6);
    const int G = gridDim.x, bx = blockIdx.x;
    const int gw = bx * NWAVES + wave, NGW = G * NWAVES;
    unsigned char* ws = args.ws;
    const float* x = args.in[0]; const float* g_mix = args.in[1]; const float* w_in = args.in[2]; const float* pool_w = args.in[3]; const float* pool_scale = args.in[4];
    const float* g_pool = args.in[5]; const float* g_attn = args.in[6]; const float* w_out = args.in[7]; const float* g_mlp = args.in[8]; const float* w_up = args.in[9];
    const float* w_down = args.in[10]; const float* g_fin = args.in[11];
    float* out = args.out;
    bf16* WCAT = (bf16*)(ws + WS_WCAT); bf16* WOUT = (bf16*)(ws + WS_WOUT); bf16* WUP = (bf16*)(ws + WS_WUP); bf16* WDN = (bf16*)(ws + WS_WDN);
    bf16* XN = (bf16*)(ws + WS_XN); bf16* PROJ = (bf16*)(ws + WS_PROJ); bf16* CAT = (bf16*)(ws + WS_CAT); bf16* OPART = (bf16*)(ws + WS_OPART);
    f32x2* ML = (f32x2*)(ws + WS_ML); bf16* HB = (bf16*)(ws + WS_H);
    const int lo = args.ph_lo, hi = args.ph_hi;
#define IN(k) (lo <= (k) && (k) < hi)
#define SEAM(k) do { if (IN(k) && IN((k) + 1)) { if ((k) == 0) { cg::this_grid().sync(); xbar = xcd_barrier_post((unsigned*)(ws + WS_BAR), (volatile LAS unsigned*)(lds + RING_BYTES + 320)); } else xcd_barrier(xbar); } } while (0)
    XcdBarrier xbar; xbar.bar = (unsigned*)(ws + WS_BAR); xbar.x = 0; xbar.st = (volatile LAS unsigned*)(lds + RING_BYTES + 320);
    if (lo == 0 && hi == N_PHASES) {
        if (bx == 0) for (int i = tid; i < XCD_BAR_WORDS; i += NTHREADS) __hip_atomic_store((unsigned*)(ws + WS_BAR) + i, 0u, __ATOMIC_RELAXED, __HIP_MEMORY_SCOPE_AGENT);
        if (tid < 2) ((volatile LAS unsigned*)(lds + RING_BYTES + 320))[tid] = 0u;
        __syncthreads();
    }

    if (IN(0)) REP(0) {
        const int pv0 = rep_ == 0 ? 0 : PROBE_VAR;
        if (pv0 == 0 || pv0 == 1)
        {
            LAS float* wt = (LAS float*)lds;
            const int f = tid & 255, kh = tid >> 8;
            for (int tile = bx; tile < 512; tile += G) {
                const int g = tile >> 7, k0 = (tile & 127) * 16;
#pragma unroll
                for (int j = 0; j < 8; ++j) { const int idx = tid + 512 * j, kk = idx >> 8, c = idx & 255; wt[kk * 256 + c] = w_in[(size_t)(k0 + kk) * INW + g * 256 + c]; }
                __syncthreads();
                float acc[8];
#pragma unroll
                for (int kk = 0; kk < 8; ++kk) acc[kk] = 0.f;
                const float* pw = pool_w + (size_t)g * 65536 + f;
                for (int cb = 0; cb < 256; cb += 32) {
                    float pv_[32];
#pragma unroll
                    for (int i = 0; i < 32; ++i) pv_[i] = pw[(cb + i) * 256];
#pragma unroll
                    for (int i = 0; i < 32; i += 4)
#pragma unroll
                        for (int kk = 0; kk < 8; ++kk) { const f32x4 v = *(const LAS f32x4*)(wt + (8 * kh + kk) * 256 + cb + i); acc[kk] += (pv_[i] * v.x + pv_[i + 1] * v.y) + (pv_[i + 2] * v.z + pv_[i + 3] * v.w); }
                }
                const float sc = pool_scale[g * 256 + f];
                v4u o; o.x = pk2(acc[0] * sc, acc[1] * sc); o.y = pk2(acc[2] * sc, acc[3] * sc); o.z = pk2(acc[4] * sc, acc[5] * sc); o.w = pk2(acc[6] * sc, acc[7] * sc);
                *(v4u*)(WCAT + (size_t)(g * 256 + f) * DM + k0 + 8 * kh) = o;
                __syncthreads();
            }
        }
        if (pv0 == 0 || pv0 == 2)
        {
            LAS float* scr = (LAS float*)(lds + wave * 16384);
            constexpr int I_QKV = (DM / 64) * (3 * ATTW / 32), I_O = (DM / 64) * (DM / 32), I_U = (DM / 64) * (DFF / 32), I_D = (DFF / 64) * (DM / 32);
            for (int it = gw; it < I_QKV + I_O + I_U + I_D; it += NGW) {
                int r = it;
                if (r < I_QKV) { p0_transpose_item(w_in + POOLW, INW, DM, 3 * ATTW, WCAT, POOLW, ATTW, QSCALE, scr, r, lane); continue; } r -= I_QKV;
                if (r < I_O) { p0_transpose_item(w_out, DM, DM, DM, WOUT, 0, 0, 1.f, scr, r, lane); continue; } r -= I_O;
                if (r < I_U) { p0_transpose_item(w_up, DFF, DM, DFF, WUP, 0, 0, 1.f, scr, r, lane); continue; } r -= I_U;
                p0_transpose_item(w_down, DM, DFF, DM, WDN, 0, 0, 1.f, scr, r, lane);
            }
        }
        if (pv0 == 0 || pv0 == 3)
        for (int m = gw; m < M; m += NGW) rms_row<true>(x + (size_t)m * DM, g_mix, XN + (size_t)m * DM, lane);
    }
    SEAM(0);
    for (int xs_ = 0; xs_ < PROBE_SYNC; ++xs_) cg::this_grid().sync();
    if (IN(1)) REP(1) {
        __syncthreads();
        pg8::Gemm g{XN, WCAT, M, INW, DM}; pg8::RepOrder<(PROBE_GEMM == 1 ? 2 : 1)> S; S.init(M, INW, G, bx);
        pg8::EpiBf16Act<0> E{PROJ, PP};
        pg8::gemm_phase<pg8::EpiBf16Act<0>, pg8::RepOrder<(PROBE_GEMM == 1 ? 2 : 1)>, PG8_ALIGN, PG8_SP2>(lds, g, S, E);
    }
    SEAM(1);
    if (IN(2)) REP(2) {
        for (int u = bx; u < 768; u += G) attn_wg_unit(PROJ, OPART, ML, u, (LAS char*)lds, wave, lane, rep_ == 0 ? 0 : PROBE_VAR);
        asm volatile("s_waitcnt vmcnt(0)" ::: "memory");
        __syncthreads();
    }
    SEAM(2);
    if (IN(3)) REP(3) {
        for (int m = gw; m < M; m += NGW) merge_row(PROJ, OPART, ML, g_pool, g_attn, CAT, m, lane);
    }
    SEAM(3);
    if (IN(4)) REP(4) {
        __syncthreads();
        pg8::Gemm g{CAT, WOUT, M, DM, DM}; pg8::RepOrder<(PROBE_GEMM == 4 ? 2 : 1)> S; S.init(M, DM, G, bx);
        pg8::EpiResF32 E{x, out, DM};
        pg8::gemm_phase<pg8::EpiResF32, pg8::RepOrder<(PROBE_GEMM == 4 ? 2 : 1)>, PG8_ALIGN, PG8_SP2>(lds, g, S, E);
    }
    SEAM(4);
    if (IN(5)) REP(5) {
        for (int m = gw; m < M; m += NGW) rms_row<true>(out + (size_t)m * DM, g_mlp, XN + (size_t)m * DM, lane);
    }
    SEAM(5);
    if (IN(6)) REP(6) {
        __syncthreads();
        pg8::Gemm g{XN, WUP, M, DFF, DM}; pg8::RepOrder<(PROBE_GEMM == 6 ? 2 : 1)> S; S.init(M, DFF, G, bx);
        pg8::EpiBf16Act<2> E{HB, DFF};
        pg8::gemm_phase<pg8::EpiBf16Act<2>, pg8::RepOrder<(PROBE_GEMM == 6 ? 2 : 1)>, PG8_ALIGN, PG8_SP2>(lds, g, S, E);
    }
    SEAM(6);
    if (IN(7)) REP(7) {
        __syncthreads();
        pg8::Gemm g{HB, WDN, M, DM, DFF}; pg8::StaticOrder S; S.init(M, DM, G, bx);
        pg8::EpiResF32 E{out, out, DM};
        pg8::gemm_phase<pg8::EpiResF32, pg8::StaticOrder, PG8_ALIGN, PG8_SP2>(lds, g, S, E);
    }
    SEAM(7);
    if (IN(8)) REP(8) {
        for (int m = gw; m < M; m += NGW) rms_row<false>(out + (size_t)m * DM, g_fin, out + (size_t)m * DM, lane);
    }
#undef IN
#undef SEAM
}

extern "C" void kernel_launch(void* const* d_in, const int* in_sizes, int n_in, void* d_out, int out_size, void* d_ws, size_t ws_size, hipStream_t stream) {
    static int grid = 0;
    if (grid == 0) {
        if (n_in != 12 || in_sizes[0] != M * DM || out_size != M * DM || ws_size < WS_END) { fprintf(stderr, "kernel_launch: unexpected shapes (n_in %d, in0 %d, out %d, ws %zu); nothing launched\n", n_in, n_in > 0 ? in_sizes[0] : -1, out_size, ws_size); grid = -1; return; }
        int dev = 0, cus = 0, per_cu = 0;
        if (hipGetDevice(&dev) != hipSuccess || hipDeviceGetAttribute(&cus, hipDeviceAttributeMultiprocessorCount, dev) != hipSuccess) { fprintf(stderr, "kernel_launch: device query failed\n"); grid = -1; return; }
        if (hipFuncSetAttribute((const void*)fwd_mega, hipFuncAttributeMaxDynamicSharedMemorySize, LDS_BYTES) != hipSuccess) { fprintf(stderr, "kernel_launch: hipFuncSetAttribute failed\n"); grid = -1; return; }
        if (hipOccupancyMaxActiveBlocksPerMultiprocessor(&per_cu, (const void*)fwd_mega, NTHREADS, LDS_BYTES) != hipSuccess || per_cu < 1) { fprintf(stderr, "kernel_launch: occupancy query gave %d\n", per_cu); per_cu = 1; }
        (void)hipGetLastError();
        grid = cus * per_cu;
    }
    if (grid < 0) return;
    Args a{};
    for (int i = 0; i < 12; ++i) a.in[i] = (const float*)d_in[i];
    a.out = (float*)d_out; a.ws = (unsigned char*)d_ws;
#if MK_N_LAUNCHES == 1
    a.ph_lo = 0; a.ph_hi = N_PHASES;
    void* kargs[] = {&a};
    hipError_t e = hipLaunchCooperativeKernel((const void*)fwd_mega, dim3(grid), dim3(NTHREADS), kargs, LDS_BYTES, stream);
    if (e != hipSuccess) fprintf(stderr, "kernel_launch: cooperative launch failed: %s (grid %d)\n", hipGetErrorString(e), grid);
#else
    for (int ph = 0; ph < N_PHASES; ++ph) {
        a.ph_lo = ph; a.ph_hi = ph + 1;
        hipLaunchKernelGGL(fwd_mega, dim3(grid), dim3(NTHREADS), LDS_BYTES, stream, a);
    }
#endif
}
```

```cpp
#include <hip/hip_runtime.h>
#include <hip/hip_cooperative_groups.h>
#include <cstdio>
#include <cstdint>
#include <cmath>
namespace cg = cooperative_groups;
namespace pg8 {
#define PG8_LAS __attribute__((address_space(3)))
typedef unsigned short bf16_t;
typedef short bf16x8 __attribute__((ext_vector_type(8)));
typedef float f32x4 __attribute__((ext_vector_type(4)));
typedef unsigned u32x4 __attribute__((ext_vector_type(4)));
constexpr int BM = 256, BK = 64, HALF = 128, HTB = HALF * BK * 2  , STAGE_BYTES = 8 * HTB, NXCD = 8, WGM = 8;

__host__ __device__ __forceinline__ int lds_byte(int r, int c) { const int st = (r >> 4) * 2 + (c >> 5), rr = r & 15, cc = c & 31, ob = rr * 64 + cc * 2; return st * 1024 + (ob ^ (((ob >> 9) & 1) << 5)); }
__host__ __device__ __forceinline__ void stage_rc(int b, int& R, int& C) { const int st = b / 1024, sb = b % 1024, swz = sb ^ (((sb >> 9) & 1) << 5); R = (st >> 1) * 16 + swz / 64; C = (st & 1) * 32 + (swz % 64) / 2; }
__host__ __device__ __forceinline__ int perm32(int rho) { const int n = rho >> 4, i = rho & 15; return 8 * (i >> 2) + 4 * n + (i & 3); }

struct Unit { int pm, pn; };
struct Gemm { const bf16_t* A; const bf16_t* Bt; int M, N, K; };

struct StaticOrder {
    int nM, nN, nwg, G, c;
    __host__ __device__ void init(int M, int N, int G_, int c_) { nM = M / BM; nN = N / BM; nwg = nM * nN; G = G_; c = c_; }
    __host__ __device__ bool next(int i, Unit& u) const {
        const long L = (long)i * G + c; if (L >= nwg) return false;
        int wgid = (int)L; { const int q = nwg / NXCD, r = nwg % NXCD, xcd = wgid % NXCD, off = wgid / NXCD; wgid = (xcd < r ? xcd * (q + 1) : r * (q + 1) + (xcd - r) * q) + off; }
        const int nig = WGM * nN, gid = wgid / nig, fm = gid * WGM, gsz = (nM - fm) < WGM ? (nM - fm) : WGM;
        u.pm = fm + ((wgid % nig) % gsz); u.pn = (wgid % nig) / gsz; return true;
    }
    __device__ __forceinline__ void a_ready(const Unit&) const {}
    __device__ __forceinline__ void done(const Unit&) const {}
};

__device__ __forceinline__ unsigned cvt_pk_bf16(float lo, float hi) { unsigned r; asm volatile("v_cvt_pk_bf16_f32 %0, %1, %2" : "=v"(r) : "v"(lo), "v"(hi)); return r; }
typedef float f32x2 __attribute__((ext_vector_type(2)));
__device__ __forceinline__ f32x2 gelu_pk(f32x2 v) {
    const f32x2 av = __builtin_elementwise_abs(v), d = av * 0.2316418882f + 1.0f;
    f32x2 t; t.x = __builtin_amdgcn_rcpf(d.x); t.y = __builtin_amdgcn_rcpf(d.y);
    f32x2 q = t * 0.5307027145f + (-0.7265760135f); q = q * t + 0.7107068705f; q = q * t + (-0.142248368f); q = q * t + 0.127414796f; q = q * t;
    const f32x2 s = (v * v) * (-0.72134752044f);
    f32x2 e; e.x = __builtin_amdgcn_exp2f(s.x); e.y = __builtin_amdgcn_exp2f(s.y);
    const f32x2 m = v * (q * e), r = v - m;
    f32x2 o; o.x = v.x < 0.f ? m.x : r.x; o.y = v.y < 0.f ? m.y : r.y; return o;
}

template <int ACT  > struct EpiBf16 {
    static constexpr bool PERM = true, AFTER_DRAIN = false; static_assert(ACT == 0 || ACT == 1, "EpiBf16: ACT is 0 (none) or 1 (gelu_pk)");
    bf16_t* O; int ldc; const float* bias; int split_cols; size_t split_stride; float scale0;
    __device__ __forceinline__ void operator()(const f32x4 (&acc)[2][2][4][2], const Unit& u, int wr, int wc, int fr, int fq) const {
        const int row0 = u.pm * BM + wr * 64 + fr; int colt = u.pn * BM; bf16_t* base = O;
        float sc = 1.f; if (split_cols) { const int t = colt / split_cols; base += (size_t)t * split_stride; colt -= t * split_cols; if (t == 0) sc = scale0; }
        const int col0 = colt + wc * 32 + 8 * fq, bcol0 = u.pn * BM + wc * 32 + 8 * fq;
        f32x4 bv[2][2];
#pragma unroll
        for (int bj = 0; bj < 2; ++bj)
#pragma unroll
            for (int n = 0; n < 2; ++n) bv[bj][n] = bias ? *(const f32x4*)(bias + bcol0 + bj * HALF + 4 * n) : (f32x4){0.f, 0.f, 0.f, 0.f};
#pragma unroll
        for (int ai = 0; ai < 2; ++ai)
#pragma unroll
            for (int m = 0; m < 4; ++m) { bf16_t* rowp = base + (size_t)(row0 + ai * HALF + m * 16) * ldc + col0;
#pragma unroll
                for (int bj = 0; bj < 2; ++bj) { f32x4 v0 = acc[ai][bj][m][0] + bv[bj][0], v1 = acc[ai][bj][m][1] + bv[bj][1];
                    if (ACT == 1) { f32x2 a = gelu_pk((f32x2){v0[0], v0[1]}), b = gelu_pk((f32x2){v0[2], v0[3]}), c = gelu_pk((f32x2){v1[0], v1[1]}), d = gelu_pk((f32x2){v1[2], v1[3]});
                        v0 = (f32x4){a.x, a.y, b.x, b.y}; v1 = (f32x4){c.x, c.y, d.x, d.y}; }
                    v0 = v0 * sc; v1 = v1 * sc; u32x4 w; w.x = cvt_pk_bf16(v0[0], v0[1]); w.y = cvt_pk_bf16(v0[2], v0[3]); w.z = cvt_pk_bf16(v1[0], v1[1]); w.w = cvt_pk_bf16(v1[2], v1[3]);
                    *(u32x4*)(rowp + bj * HALF) = w; } }
    }
};
template <class Epi, class Sched, bool ALIGN_EPI = false, bool SP2 = false>
__device__ __forceinline__ void gemm_phase(PG8_LAS unsigned char* lds, const Gemm g, const Sched& S, const Epi& E) {
    const int tid = threadIdx.x, wid = __builtin_amdgcn_readfirstlane(tid >> 6), lane = tid & 63, wr = wid >> 2, wc = wid & 3, fr = lane & 15, fq = lane >> 4;
    const int K = g.K, nt = K / BK;
    unsigned voffA[2], voffB[2];
#pragma unroll
    for (int i = 0; i < 2; ++i) { int R, C; stage_rc(tid * 16 + i * 8192, R, C); const int Rb = Epi::PERM ? ((R & ~31) + perm32(R & 31)) : R;
        voffA[i] = (unsigned)(R * K + C) * 2u; voffB[i] = (unsigned)(Rb * K + C) * 2u; }
    const size_t kstep = (size_t)(BK * 2);
    const size_t hstep = (size_t)HALF * K * 2;
    const size_t tstep = 2 * hstep;
    const unsigned ldsw = (unsigned)wid * 1024u;
    const int aoff = lds_byte(wr * 64 + fr, fq * 8), boff = lds_byte(wc * 32 + fr, fq * 8);
#define PG8_SA(b, h) (((b) * 2 + (h)) * HTB)
#define PG8_SB(b, h) ((4 + (b) * 2 + (h)) * HTB)
#define PG8_STAGE(bufoff, gbase, voff) do { _Pragma("unroll") for (int _i = 0; _i < 2; ++_i) \
        __builtin_amdgcn_global_load_lds((const unsigned*)((const char*)(gbase) + (voff)[_i]), (PG8_LAS unsigned*)(lds + (bufoff) + ldsw + _i * 8192), 16, 0, 0); } while (0)
#define PG8_LDA(dst, b, h) do { _Pragma("unroll") for (int m = 0; m < 4; ++m) _Pragma("unroll") for (int k = 0; k < 2; ++k) dst[m][k] = *(const PG8_LAS bf16x8*)(lds + PG8_SA(b, h) + aoff + m * 2048 + k * 1024); } while (0)
#define PG8_LDB(dst, b, h) do { _Pragma("unroll") for (int n = 0; n < 2; ++n) _Pragma("unroll") for (int k = 0; k < 2; ++k) dst[n][k] = *(const PG8_LAS bf16x8*)(lds + PG8_SB(b, h) + boff + n * 2048 + k * 1024); } while (0)
#define PG8_MMA(ai, bj, At, Bt) do { __builtin_amdgcn_s_setprio(1); _Pragma("unroll") for (int m = 0; m < 4; ++m) _Pragma("unroll") for (int n = 0; n < 2; ++n) _Pragma("unroll") for (int k = 0; k < 2; ++k) \
        acc[ai][bj][m][n] = __builtin_amdgcn_mfma_f32_16x16x32_bf16(Bt[n][k], At[m][k], acc[ai][bj][m][n], 0, 0, 0); __builtin_amdgcn_s_setprio(0); } while (0)
#define PG8_WAIT_V(n) asm volatile("s_waitcnt vmcnt(" #n ")" ::: "memory")
#define PG8_WAIT_L(n) asm volatile("s_waitcnt lgkmcnt(" #n ")" ::: "memory")
#define PG8_BAR __builtin_amdgcn_s_barrier()
#define PG8_SCHED __builtin_amdgcn_sched_barrier(0)
    Unit cur, nxt; int ui = 0;
    if (!S.next(0, cur)) return;
    f32x4 acc[2][2][4][2];
#pragma unroll
    for (int a = 0; a < 2; ++a)
#pragma unroll
        for (int b = 0; b < 2; ++b)
#pragma unroll
            for (int m = 0; m < 4; ++m)
#pragma unroll
                for (int n = 0; n < 2; ++n) acc[a][b][m][n] = (f32x4){0.f, 0.f, 0.f, 0.f};
    bf16x8 At[4][2], B0[2][2], B1[2][2];
    const char* cA = (const char*)g.A + (size_t)cur.pm * tstep; const char* cB = (const char*)g.Bt + (size_t)cur.pn * tstep;
    S.a_ready(cur);
    if constexpr (SP2) {
        PG8_STAGE(PG8_SB(0, 0), cB, voffB); PG8_STAGE(PG8_SB(0, 1), cB + hstep, voffB); PG8_STAGE(PG8_SA(0, 0), cA, voffA); PG8_STAGE(PG8_SA(0, 1), cA + hstep, voffA);
        if (wr == 1) PG8_BAR;
        PG8_WAIT_V(2); PG8_BAR;
        PG8_STAGE(PG8_SB(1, 0), cB + kstep, voffB); PG8_STAGE(PG8_SA(1, 0), cA + kstep, voffA); PG8_STAGE(PG8_SB(1, 1), cB + hstep + kstep, voffB);
        PG8_WAIT_V(6); PG8_BAR;
    } else {
        PG8_STAGE(PG8_SB(0, 0), cB, voffB); PG8_STAGE(PG8_SA(0, 0), cA, voffA); PG8_STAGE(PG8_SB(0, 1), cB + hstep, voffB); PG8_STAGE(PG8_SA(0, 1), cA + hstep, voffA);
        if (wr == 1) PG8_BAR;
        PG8_WAIT_V(4); PG8_BAR;
        PG8_STAGE(PG8_SB(1, 0), cB + kstep, voffB); PG8_STAGE(PG8_SA(1, 0), cA + kstep, voffA); PG8_STAGE(PG8_SB(1, 1), cB + hstep + kstep, voffB);
        PG8_WAIT_V(6); PG8_BAR;
    }
    for (;;) {
        const bool has_next = S.next(ui + 1, nxt);
        const char* nA = has_next ? (const char*)g.A + (size_t)nxt.pm * tstep : cA; const char* nB = has_next ? (const char*)g.Bt + (size_t)nxt.pn * tstep : cB;
        for (int t = 0; t < nt; t += 2) {
            const bool last = (t == nt - 2);
            const char* a1 = cA + (size_t)(t + 1) * kstep;
            const char* a2 = last ? nA : cA + (size_t)(t + 2) * kstep; const char* b2 = last ? nB : cB + (size_t)(t + 2) * kstep;
            const char* a3 = a2 + kstep; const char* b3 = b2 + kstep;
            if (last && has_next) S.a_ready(nxt);
            if constexpr (SP2) {
            PG8_LDB(B0, 0, 0); PG8_LDB(B1, 0, 1); PG8_SCHED; PG8_LDA(At, 0, 0); PG8_STAGE(PG8_SA(1, 1), a1 + hstep, voffA);
            PG8_WAIT_V(8); PG8_WAIT_L(0); PG8_BAR; PG8_MMA(0, 0, At, B0); PG8_MMA(0, 1, At, B1); PG8_BAR; PG8_SCHED;
            PG8_LDA(At, 0, 1); PG8_STAGE(PG8_SB(0, 0), b2, voffB); PG8_STAGE(PG8_SB(0, 1), b2 + hstep, voffB); PG8_STAGE(PG8_SA(0, 0), a2, voffA);
            PG8_WAIT_V(8); PG8_WAIT_L(0); PG8_BAR; PG8_MMA(1, 0, At, B0); PG8_MMA(1, 1, At, B1); PG8_BAR; PG8_SCHED;
            PG8_LDB(B0, 1, 0); PG8_LDB(B1, 1, 1); PG8_SCHED; PG8_LDA(At, 1, 0); PG8_STAGE(PG8_SA(0, 1), a2 + hstep, voffA);
            PG8_WAIT_V(8); PG8_WAIT_L(0); PG8_BAR; PG8_MMA(0, 0, At, B0); PG8_MMA(0, 1, At, B1); PG8_BAR; PG8_SCHED;
            PG8_LDA(At, 1, 1); PG8_STAGE(PG8_SB(1, 0), b3, voffB); PG8_STAGE(PG8_SB(1, 1), b3 + hstep, voffB); PG8_STAGE(PG8_SA(1, 0), a3, voffA);
            PG8_WAIT_V(8); PG8_WAIT_L(0); PG8_BAR; PG8_MMA(1, 0, At, B0); PG8_MMA(1, 1, At, B1); PG8_BAR; PG8_SCHED;
            } else {
            PG8_LDB(B0, 0, 0); PG8_SCHED; PG8_LDA(At, 0, 0); PG8_STAGE(PG8_SA(1, 1), a1 + hstep, voffA);
            PG8_WAIT_L(8); PG8_BAR; PG8_WAIT_L(0); PG8_MMA(0, 0, At, B0); PG8_BAR; PG8_SCHED;
            PG8_LDB(B1, 0, 1); PG8_STAGE(PG8_SB(0, 0), b2, voffB);
            PG8_BAR; PG8_WAIT_L(0); PG8_MMA(0, 1, At, B1); PG8_BAR;
            PG8_LDA(At, 0, 1); PG8_STAGE(PG8_SA(0, 0), a2, voffA);
            PG8_BAR; PG8_WAIT_L(0); PG8_MMA(1, 0, At, B0); PG8_BAR; PG8_SCHED;
            PG8_STAGE(PG8_SB(0, 1), b2 + hstep, voffB);
            PG8_WAIT_V(6); PG8_BAR; PG8_MMA(1, 1, At, B1); PG8_BAR;
            PG8_LDB(B0, 1, 0); PG8_SCHED; PG8_LDA(At, 1, 0); PG8_STAGE(PG8_SA(0, 1), a2 + hstep, voffA);
            PG8_WAIT_L(8); PG8_BAR; PG8_WAIT_L(0); PG8_MMA(0, 0, At, B0); PG8_BAR; PG8_SCHED;
            PG8_LDB(B1, 1, 1); PG8_STAGE(PG8_SB(1, 0), b3, voffB);
            PG8_BAR; PG8_WAIT_L(0); PG8_MMA(0, 1, At, B1); PG8_BAR;
            PG8_LDA(At, 1, 1); PG8_STAGE(PG8_SA(1, 0), a3, voffA);
            PG8_BAR; PG8_WAIT_L(0); PG8_MMA(1, 0, At, B0); PG8_BAR; PG8_SCHED;
            PG8_STAGE(PG8_SB(1, 1), b3 + hstep, voffB);
            PG8_WAIT_V(6); PG8_BAR; PG8_MMA(1, 1, At, B1); PG8_BAR;
            }
        }
        if constexpr (ALIGN_EPI) { if (wr == 0) PG8_BAR; }
        if constexpr (!Epi::AFTER_DRAIN) { E(acc, cur, wr, wc, fr, fq); S.done(cur); }
        if (!has_next) break;
#pragma unroll
        for (int a = 0; a < 2; ++a)
#pragma unroll
            for (int b = 0; b < 2; ++b)
#pragma unroll
                for (int m = 0; m < 4; ++m)
#pragma unroll
                    for (int n = 0; n < 2; ++n) acc[a][b][m][n] = (f32x4){0.f, 0.f, 0.f, 0.f};
        cur = nxt; cA = nA; cB = nB; ++ui;
        if constexpr (ALIGN_EPI) { if (wr == 1) PG8_BAR; }
    }
    PG8_WAIT_V(0);
    if constexpr (!ALIGN_EPI) { if (wr == 0) PG8_BAR; }
    PG8_BAR;
    if constexpr (Epi::AFTER_DRAIN) { E.fused(acc, cur, wr, wc, fr, fq, lds, wid, lane); S.done(cur); }
#undef PG8_SA
#undef PG8_SB
#undef PG8_STAGE
#undef PG8_LDA
#undef PG8_LDB
#undef PG8_MMA
#undef PG8_WAIT_V
#undef PG8_WAIT_L
#undef PG8_BAR
#undef PG8_SCHED
}
}
#define PG8_SP2 true
#define PG8_ALIGN true

namespace pg8 {
template <int ACT  > struct EpiBf16Act {
    static constexpr bool PERM = true, AFTER_DRAIN = false;
    bf16_t* O; int ldc; const float* ssq; float inv_n, eps;
    __device__ __forceinline__ void operator()(const f32x4 (&acc)[2][2][4][2], const Unit& u, int wr, int wc, int fr, int fq) const {
        const int row0 = u.pm * BM + wr * 64 + fr; const int col0 = u.pn * BM + wc * 32 + 8 * fq;
#pragma unroll
        for (int ai = 0; ai < 2; ++ai)
#pragma unroll
            for (int m = 0; m < 4; ++m) { bf16_t* rowp = O + (size_t)(row0 + ai * HALF + m * 16) * ldc + col0;
                const float r2 = (ACT == 2 && ssq) ? 1.0f / (ssq[row0 + ai * HALF + m * 16] * inv_n + eps) : 1.0f;
#pragma unroll
                for (int bj = 0; bj < 2; ++bj) { f32x4 v0 = acc[ai][bj][m][0], v1 = acc[ai][bj][m][1];
                    if (ACT == 2) {
#pragma unroll
                        for (int e = 0; e < 4; ++e) { const float a = fmaxf(v0[e], 0.f), b = fmaxf(v1[e], 0.f); v0[e] = a * a * r2; v1[e] = b * b * r2; } }
                    u32x4 w; w.x = cvt_pk_bf16(v0[0], v0[1]); w.y = cvt_pk_bf16(v0[2], v0[3]); w.z = cvt_pk_bf16(v1[0], v1[1]); w.w = cvt_pk_bf16(v1[2], v1[3]);
                    *(u32x4*)(rowp + bj * HALF) = w; } }
    }
};
template <bool BASE_BF16> struct EpiResBf16 {
    static constexpr bool PERM = true, AFTER_DRAIN = false;
    const void* base; bf16_t* xb; int ldc; float* ssq;
    __device__ __forceinline__ void operator()(const f32x4 (&acc)[2][2][4][2], const Unit& u, int wr, int wc, int fr, int fq) const {
        const int row0 = u.pm * BM + wr * 64 + fr; const int col0 = u.pn * BM + wc * 32 + 8 * fq;
#pragma unroll
        for (int ai = 0; ai < 2; ++ai)
#pragma unroll
            for (int m = 0; m < 4; ++m) { const int row = row0 + ai * HALF + m * 16; const size_t off = (size_t)row * ldc + col0; float sq = 0.f;
#pragma unroll
                for (int bj = 0; bj < 2; ++bj) {
                    f32x4 b0, b1;
                    if (BASE_BF16) { const u32x4 w = *(const u32x4*)((const bf16_t*)base + off + bj * HALF);
                        b0 = (f32x4){__builtin_bit_cast(float, w.x << 16), __builtin_bit_cast(float, w.x & 0xffff0000u), __builtin_bit_cast(float, w.y << 16), __builtin_bit_cast(float, w.y & 0xffff0000u)};
                        b1 = (f32x4){__builtin_bit_cast(float, w.z << 16), __builtin_bit_cast(float, w.z & 0xffff0000u), __builtin_bit_cast(float, w.w << 16), __builtin_bit_cast(float, w.w & 0xffff0000u)}; }
                    else { b0 = *(const f32x4*)((const float*)base + off + bj * HALF); b1 = *(const f32x4*)((const float*)base + off + bj * HALF + 4); }
                    const f32x4 v0 = b0 + acc[ai][bj][m][0], v1 = b1 + acc[ai][bj][m][1];
                    sq += (v0[0] * v0[0] + v0[1] * v0[1]) + (v0[2] * v0[2] + v0[3] * v0[3]) + (v1[0] * v1[0] + v1[1] * v1[1]) + (v1[2] * v1[2] + v1[3] * v1[3]);
                    u32x4 w; w.x = cvt_pk_bf16(v0[0], v0[1]); w.y = cvt_pk_bf16(v0[2], v0[3]); w.z = cvt_pk_bf16(v1[0], v1[1]); w.w = cvt_pk_bf16(v1[2], v1[3]);
                    *(u32x4*)(xb + off + bj * HALF) = w; }
                sq += __shfl_xor(sq, 16); sq += __shfl_xor(sq, 32); if (fq == 0) atomicAdd(ssq + row, sq); }
    }
};
}

namespace pg8 {
template <int REPN> struct RepOrder {
    StaticOrder b;
    __host__ __device__ void init(int M, int N, int G_, int c_) { b.init(M, N, G_, c_); }
    __host__ __device__ bool next(int i, Unit& u) const { return b.next(i / REPN, u); }
    __device__ __forceinline__ void a_ready(const Unit&) const {}
    __device__ __forceinline__ void done(const Unit&) const {}
};
}
constexpr int BATCH = 2, SEQ = 16384, DM = 2048, M = BATCH * SEQ;
constexpr int POOLW = 1024, ATTW = 1024, NHEAD = 8, HD = 128, INW = 4096, DFF = 8192;
constexpr int PP = INW + 136;
constexpr float EPS = 1e-6f;
constexpr float QSCALE = 0.08838834764831845f * 1.4426950408889634f;
constexpr float LOG2E = 1.4426950408889634f;
constexpr int NWAVES = 8, NTHREADS = 512;

constexpr size_t MiB = 1u << 20;
constexpr size_t WS_BAR = 16384;
constexpr size_t WS_SSQ = 1 * MiB;
constexpr size_t WS_WCAT = 2 * MiB;
constexpr size_t WS_WOUT = 18 * MiB;
constexpr size_t WS_WUP = 26 * MiB;
constexpr size_t WS_WDN = 58 * MiB;
constexpr size_t WS_XN = 96 * MiB;
constexpr size_t WS_PROJ = 224 * MiB;
constexpr size_t WS_CAT = 496 * MiB;
constexpr size_t WS_OPART = 624 * MiB;
constexpr size_t WS_ML = 816 * MiB;
constexpr size_t WS_H = 224 * MiB;
constexpr size_t WS_END = 822 * MiB;
static_assert(WS_PROJ + (size_t)M * PP * 2 <= WS_CAT, "proj fits");

constexpr int RING_BYTES = 131072;
constexpr int LDS_BYTES = 147456;

#define LAS __attribute__((address_space(3)))
typedef unsigned short bf16;
typedef unsigned v4u __attribute__((ext_vector_type(4)));
typedef unsigned v2u __attribute__((ext_vector_type(2)));
typedef float f32x4 __attribute__((ext_vector_type(4)));
typedef float f32x2 __attribute__((ext_vector_type(2)));
typedef float f32x16 __attribute__((ext_vector_type(16)));
typedef short bf16x8 __attribute__((ext_vector_type(8)));
typedef short s16x4 __attribute__((ext_vector_type(4)));

__device__ __forceinline__ unsigned f2bf(float f) { unsigned u = __builtin_bit_cast(unsigned, f); return (u + 0x7fffu + ((u >> 16) & 1u)) >> 16; }
__device__ __forceinline__ unsigned pk2(float lo, float hi) { return f2bf(lo) | (f2bf(hi) << 16); }
__device__ __forceinline__ float bflo(unsigned w) { return __builtin_bit_cast(float, w << 16); }
__device__ __forceinline__ float bfhi(unsigned w) { return __builtin_bit_cast(float, w & 0xffff0000u); }
__device__ __forceinline__ float wave_sum(float v) {
#pragma unroll
    for (int o = 1; o < 64; o <<= 1) v += __shfl_xor(v, o);
    return v;
}

__device__ __forceinline__ void p0_transpose_item(const float* W, int ldw, int K, int N, bf16* WT, int row_off, int nscale, float sc, const float* kscale, LAS float* scr, int item, int lane) {
    const int nblk = N / 32, kb = item / nblk, nb = item % nblk, k0 = 64 * kb, n0 = 32 * nb;
    const float s = (n0 < nscale) ? sc : 1.0f;
    f32x4 wv[8];
#pragma unroll
    for (int i = 0; i < 8; ++i) wv[i] = *(const f32x4*)(W + (size_t)(k0 + 8 * i + (lane >> 3)) * ldw + n0 + 4 * (lane & 7));
#pragma unroll
    for (int i = 0; i < 8; ++i) { const float sk = kscale ? s * kscale[k0 + 8 * i + (lane >> 3)] : s; LAS float* d = scr + (8 * i + (lane >> 3)) * 33 + 4 * (lane & 7); d[0] = wv[i].x * sk; d[1] = wv[i].y * sk; d[2] = wv[i].z * sk; d[3] = wv[i].w * sk; }
    asm volatile("s_waitcnt lgkmcnt(0)" ::: "memory");
    const int c = lane & 7;
#pragma unroll
    for (int j = 0; j < 4; ++j) { const int n = (lane >> 3) + 8 * j; const LAS float* sp = scr + (8 * c) * 33 + n;
        v4u o; o.x = pk2(sp[0 * 33], sp[1 * 33]); o.y = pk2(sp[2 * 33], sp[3 * 33]); o.z = pk2(sp[4 * 33], sp[5 * 33]); o.w = pk2(sp[6 * 33], sp[7 * 33]);
        *(v4u*)(WT + (size_t)(row_off + n0 + n) * K + k0 + 8 * c) = o; }
    asm volatile("s_waitcnt lgkmcnt(0)" ::: "memory");
}
template <bool BF> __device__ __forceinline__ void rms_row(const float* xrow, const float* g, void* orow, int lane) {
    const f32x4* xr = (const f32x4*)xrow + lane; const f32x4* gr = (const f32x4*)g + lane;
    f32x4 v[8]; float s = 0.f;
#pragma unroll
    for (int j = 0; j < 8; ++j) { v[j] = xr[64 * j]; s += (v[j].x * v[j].x + v[j].y * v[j].y) + (v[j].z * v[j].z + v[j].w * v[j].w); }
    const float rstd = 1.0f / sqrtf(wave_sum(s) * (1.0f / DM) + EPS);
#pragma unroll
    for (int j = 0; j < 8; ++j) { const f32x4 gg = gr[64 * j]; const f32x4 o = v[j] * rstd * gg;
        if (BF) { v2u w; w.x = pk2(o.x, o.y); w.y = pk2(o.z, o.w); ((v2u*)orow)[64 * j + lane] = w; }
        else ((f32x4*)orow)[64 * j + lane] = o; }
}

constexpr int TILE_B = 8192;
constexpr int WAVE_LDS = 2 * TILE_B;
__device__ __forceinline__ int crow(int r, int hi) { return (r & 3) + 8 * (r >> 2) + 4 * hi; }
__device__ __forceinline__ int swz16(int row) { return ((row & 3) << 2) | ((row >> 2) & 3); }
__device__ __forceinline__ s16x4 vtr(const LAS char* p) { typedef short v4i16_t __attribute__((ext_vector_type(4))); return __builtin_bit_cast(s16x4, __builtin_amdgcn_ds_read_tr16_b64_v4i16((LAS v4i16_t*)p)); }
__device__ __forceinline__ unsigned cvtpk(float lo, float hi) { unsigned r; asm("v_cvt_pk_bf16_f32 %0, %1, %2" : "=v"(r) : "v"(lo), "v"(hi)); return r; }

constexpr int ATT_P = 3, ATT_R = 4, ATT_STEPS = 36, SLOT_B = 2 * TILE_B, OST_OFF = ATT_R * SLOT_B;
__device__ __forceinline__ void attn_wg_unit(const bf16* __restrict__ proj, bf16* __restrict__ opart, f32x2* __restrict__ ml, int wgu, LAS char* lds, int wave, int lane, const int pv) {
    const int p = wgu >> 8, rem = wgu & 255, bh = rem >> 4, b = bh >> 3, h = bh & 7, blk0 = (rem & 15) * 32;
    const int ls = 2 * p, r = blk0 >> (9 - ls), ib0 = blk0 & ((512 >> ls) - 1);
    const int q = lane & 31, hi = lane >> 5;
    const size_t rowbase = (size_t)b * SEQ + r;
    const float sl = __builtin_amdgcn_exp2f(-(float)(h + 1)) * LOG2E * (float)(1 << ls);
    const float b4 = sl * (float)(4 * hi);
    LAS char* ost = lds + OST_OFF + wave * TILE_B;
    const int lr = lane >> 4, c0 = (lane & 15) ^ (lr << 2);
    const int swzq = swz16(q);
    const int kb = q * 256 + 16 * (hi ^ swzq);
    const int qq = (lane & 15) >> 2, pp = lane & 3, bk = (lane >> 4) & 1;
    const int vb = TILE_B + (4 * hi + qq) * 256 + 8 * (pp & 1) + 16 * ((2 * bk + (pp >> 1)) ^ hi ^ (qq << 2));
    const int ob = q * 256 + 8 * hi + 16 * swzq;
    const size_t rstep = ((size_t)PP * 2) << ls;
    const char* KVu = (const char*)(proj + rowbase * PP + POOLW + ATTW + h * HD) + (size_t)(4 * wave) * rstep;
    const unsigned voff = (unsigned)((((size_t)lr << ls) * PP + (c0 ^ (wave & 3)) * 8) * 2);
    const int kbmax = (512 >> ls) - 1;
#define ATT_DMA(t_) do { int kbi_ = ib0 - 4 + (t_); kbi_ = kbi_ < 0 ? 0 : (kbi_ > kbmax ? kbmax : kbi_); if (pv == 3) kbi_ = 0; const char* ub_ = KVu + (size_t)(kbi_ * 32) * rstep + voff; \
        LAS char* sl_ = lds + ((t_) & (ATT_R - 1)) * SLOT_B + wave * 1024; \
        __builtin_amdgcn_global_load_lds((const unsigned*)ub_, (LAS unsigned*)sl_, 16, 0, 0); \
        __builtin_amdgcn_global_load_lds((const unsigned*)(ub_ + ATTW * 2), (LAS unsigned*)(sl_ + TILE_B), 16, 0, 0); } while (0)
    const char* Qu = (const char*)(proj + rowbase * PP + POOLW + h * HD);
    unsigned voffq[4];
#pragma unroll
    for (int x = 0; x < 4; ++x) voffq[x] = (unsigned)((((size_t)lr << ls) * PP + (c0 ^ x) * 8) * 2);
#define ATT_QDMA(j_) do { const char* uq_ = Qu + (size_t)((ib0 + (j_)) * 32) * rstep; _Pragma("unroll") for (int jj_ = 0; jj_ < 8; ++jj_) \
        __builtin_amdgcn_global_load_lds((const unsigned*)(uq_ + (size_t)(4 * jj_) * rstep + voffq[jj_ & 3]), (LAS unsigned*)(ost + jj_ * 1024), 16, 0, 0); } while (0)
    asm volatile("s_waitcnt lgkmcnt(0)" ::: "memory");
    __builtin_amdgcn_s_barrier();
    asm volatile("" ::: "memory");
    int jcur = wave;
    ATT_QDMA(jcur);
    ATT_DMA(0); ATT_DMA(1); ATT_DMA(2);
    float m = -1e30f, l = 0.f;
    f32x16 o[4];
#pragma unroll
    for (int c = 0; c < 4; ++c)
#pragma unroll
        for (int e = 0; e < 16; ++e) o[c][e] = 0.f;
#define ATT_FINALIZE() do { \
        float lt_; { auto rr_ = __builtin_amdgcn_permlane32_swap(__float_as_uint(l), __float_as_uint(l), false, false); lt_ = __uint_as_float(rr_[0]) + __uint_as_float(rr_[1]); } \
        const float inv_ = 1.0f / lt_; const size_t qrow_ = rowbase + ((size_t)((ib0 + jcur) * 32 + q) << ls); \
        _Pragma("unroll") for (int c = 0; c < 4; ++c) _Pragma("unroll") for (int g4 = 0; g4 < 4; ++g4) { v2u w_; w_.x = cvtpk(o[c][4 * g4] * inv_, o[c][4 * g4 + 1] * inv_); w_.y = cvtpk(o[c][4 * g4 + 2] * inv_, o[c][4 * g4 + 3] * inv_); \
            *(LAS v2u*)(ost + (ob ^ (16 * (4 * c + g4)))) = w_; } \
        asm volatile("s_waitcnt lgkmcnt(0)" ::: "memory"); \
        bf16* Ob_ = opart + ((size_t)p * M + rowbase) * ATTW + h * HD; \
        if (pv == 0) { _Pragma("unroll") for (int j = 0; j < 8; ++j) { const v4u w_ = *(const LAS v4u*)(ost + j * 1024 + lane * 16); \
            *(v4u*)(Ob_ + ((size_t)((ib0 + jcur) * 32 + 4 * j + lr) << ls) * ATTW + (c0 ^ (j & 3)) * 8) = w_; } \
            if (hi == 0) ml[((size_t)p * M + qrow_) * NHEAD + h] = (f32x2){m, lt_}; } \
        asm volatile("s_waitcnt lgkmcnt(0)" ::: "memory"); \
        m = -1e30f; l = 0.f; \
        _Pragma("unroll") for (int c = 0; c < 4; ++c) _Pragma("unroll") for (int e = 0; e < 16; ++e) o[c][e] = 0.f; } while (0)
    for (int t = 0; t < ATT_STEPS; ++t) {
        asm volatile("s_waitcnt vmcnt(4)" ::: "memory");
        __builtin_amdgcn_s_barrier();
        asm volatile("" ::: "memory");
        ATT_DMA(t + ATT_P);
        const int kt = t - jcur;
        if (kt == 5) {
            ATT_FINALIZE();
            jcur += 8;
            if (jcur < 32) ATT_QDMA(jcur);
        } else if (kt >= 0 && kt <= 4 && ib0 - 4 + t >= 0 && pv != 4) {
            const LAS char* slot = lds + (t & (ATT_R - 1)) * SLOT_B;
            f32x16 s;
#pragma unroll
            for (int e = 0; e < 16; ++e) s[e] = 0.f;
#pragma unroll
            for (int ss = 0; ss < 8; ++ss) {
                const bf16x8 kf = *(const LAS bf16x8*)(slot + (kb ^ (32 * ss))), qv = *(const LAS bf16x8*)(ost + (kb ^ (32 * ss)));
                s = __builtin_amdgcn_mfma_f32_32x32x16_bf16(kf, qv, s, 0, 0, 0); }
            s16x4 vr[4][4];
#pragma unroll
            for (int c = 0; c < 2; ++c)
#pragma unroll
                for (int kk = 0; kk < 4; ++kk) vr[c][kk] = vtr(slot + ((vb ^ (16 * ((4 * c) ^ (2 * (kk & 1))))) + 2048 * kk));
            const int dbase = q + 128 - 32 * kt;
            float mx = -INFINITY;
            if (kt == 0 || kt == 4) {
#pragma unroll
                for (int e = 0; e < 16; ++e) { const int dl = dbase - crow(e, hi); float v = __builtin_fmaf(sl, (float)((e & 3) + 8 * (e >> 2)), s[e]); v = (dl < 0 || dl > 128) ? -INFINITY : v; s[e] = v; mx = fmaxf(mx, v); }
            } else {
#pragma unroll
                for (int e = 0; e < 16; ++e) { const float v = __builtin_fmaf(sl, (float)((e & 3) + 8 * (e >> 2)), s[e]); s[e] = v; mx = fmaxf(mx, v); }
            }
            mx += b4;
            { auto rr = __builtin_amdgcn_permlane32_swap(__float_as_uint(mx), __float_as_uint(mx), false, false); mx = fmaxf(__uint_as_float(rr[0]), __uint_as_float(rr[1])); }
            const float sd = sl * (float)dbase;
            const float mc = mx - sd;
            if (__any(mc > m + 8.0f)) {
                const float mn = fmaxf(m, mc), alpha = __builtin_amdgcn_exp2f(m - mn);
                m = mn; l *= alpha;
#pragma unroll
                for (int c = 0; c < 4; ++c)
#pragma unroll
                    for (int e = 0; e < 16; ++e) o[c][e] *= alpha;
            }
            const float sh = m + sd - b4;
            float ps = 0.f;
#pragma unroll
            for (int e = 0; e < 16; ++e) { s[e] = __builtin_amdgcn_exp2f(s[e] - sh); ps += s[e]; }
            l += ps;
            v4u pw0, pw1;
            pw0.x = cvtpk(s[0], s[1]); pw0.y = cvtpk(s[2], s[3]); pw0.z = cvtpk(s[4], s[5]); pw0.w = cvtpk(s[6], s[7]);
            pw1.x = cvtpk(s[8], s[9]); pw1.y = cvtpk(s[10], s[11]); pw1.z = cvtpk(s[12], s[13]); pw1.w = cvtpk(s[14], s[15]);
            const bf16x8 pf0 = __builtin_bit_cast(bf16x8, pw0), pf1 = __builtin_bit_cast(bf16x8, pw1);
#pragma unroll
            for (int c = 2; c < 4; ++c)
#pragma unroll
                for (int kk = 0; kk < 4; ++kk) vr[c][kk] = vtr(slot + ((vb ^ (16 * ((4 * c) ^ (2 * (kk & 1))))) + 2048 * kk));
#pragma unroll
            for (int c = 0; c < 4; ++c) {
                const bf16x8 vf0 = (bf16x8){vr[c][0][0], vr[c][0][1], vr[c][0][2], vr[c][0][3], vr[c][1][0], vr[c][1][1], vr[c][1][2], vr[c][1][3]};
                const bf16x8 vf1 = (bf16x8){vr[c][2][0], vr[c][2][1], vr[c][2][2], vr[c][2][3], vr[c][3][0], vr[c][3][1], vr[c][3][2], vr[c][3][3]};
                o[c] = __builtin_amdgcn_mfma_f32_32x32x16_bf16(vf0, pf0, o[c], 0, 0, 0);
                o[c] = __builtin_amdgcn_mfma_f32_32x32x16_bf16(vf1, pf1, o[c], 0, 0, 0); }
            asm volatile("s_waitcnt lgkmcnt(0)" ::: "memory");
        }
    }
    if (jcur < 32) ATT_FINALIZE();
#undef ATT_FINALIZE
#undef ATT_DMA
#undef ATT_QDMA
}

__device__ __forceinline__ void merge_row(const bf16* __restrict__ proj, const bf16* __restrict__ opart, const f32x2* __restrict__ ml, const float* __restrict__ gp, const float* __restrict__ ga,
                                          bf16* __restrict__ cat, int row, int lane) {
    const int t = row & (SEQ - 1), c0 = lane * 16;
    float y[16];
    {
        const int w = 2 << (lane >> 4), cnt = (t + 1 < w) ? t + 1 : w;
        float acc[16];
#pragma unroll
        for (int j = 0; j < 16; ++j) acc[j] = 0.f;
#pragma unroll
        for (int hb = 0; hb < 2; ++hb) {
            v4u za[8], zb[8];
#pragma unroll
            for (int i = 0; i < 8; ++i) { const int ii = 8 * hb + i; const v4u* zp = (const v4u*)(proj + (size_t)(row - (ii < cnt ? ii : 0)) * PP + c0); za[i] = zp[0]; zb[i] = zp[1]; }
#pragma unroll
            for (int i = 0; i < 8; ++i) {
                const int ii = 8 * hb + i; const v4u a = za[i], b = zb[i]; const float mk = (ii == 0) ? -(float)(cnt - 1) : ((ii < cnt) ? 1.0f : 0.0f);
                float f[16] = {bflo(a.x), bfhi(a.x), bflo(a.y), bfhi(a.y), bflo(a.z), bfhi(a.z), bflo(a.w), bfhi(a.w), bflo(b.x), bfhi(b.x), bflo(b.y), bfhi(b.y), bflo(b.z), bfhi(b.z), bflo(b.w), bfhi(b.w)};
#pragma unroll
                for (int j = 0; j < 16; ++j) acc[j] += mk * f[j];
            }
        }
        const float ic = 1.0f / (float)cnt;
#pragma unroll
        for (int j = 0; j < 16; ++j) y[j] = acc[j] * ic;
    }
    {
        float ss = 0.f;
#pragma unroll
        for (int j = 0; j < 16; ++j) ss += y[j] * y[j];
        const float rstd = 1.0f / sqrtf(wave_sum(ss) * (1.0f / POOLW) + EPS);
        const f32x4* g4 = (const f32x4*)(gp + c0);
        v4u o0, o1; const f32x4 ga0 = g4[0], ga1 = g4[1], ga2 = g4[2], ga3 = g4[3];
        o0.x = pk2(y[0] * rstd * ga0.x, y[1] * rstd * ga0.y); o0.y = pk2(y[2] * rstd * ga0.z, y[3] * rstd * ga0.w);
        o0.z = pk2(y[4] * rstd * ga1.x, y[5] * rstd * ga1.y); o0.w = pk2(y[6] * rstd * ga1.z, y[7] * rstd * ga1.w);
        o1.x = pk2(y[8] * rstd * ga2.x, y[9] * rstd * ga2.y); o1.y = pk2(y[10] * rstd * ga2.z, y[11] * rstd * ga2.w);
        o1.z = pk2(y[12] * rstd * ga3.x, y[13] * rstd * ga3.y); o1.w = pk2(y[14] * rstd * ga3.z, y[15] * rstd * ga3.w);
        v4u* cp = (v4u*)(cat + (size_t)row * DM + c0); cp[0] = o0; cp[1] = o1;
    }
    {
        const int hd = lane >> 3;
        const f32x2 s0 = ml[((size_t)0 * M + row) * NHEAD + hd], s1 = ml[((size_t)1 * M + row) * NHEAD + hd], s2 = ml[((size_t)2 * M + row) * NHEAD + hd];
        const float mx = fmaxf(s0.x, fmaxf(s1.x, s2.x));
        float w0 = __builtin_amdgcn_exp2f(s0.x - mx) * s0.y, w1 = __builtin_amdgcn_exp2f(s1.x - mx) * s1.y, w2 = __builtin_amdgcn_exp2f(s2.x - mx) * s2.y;
        const float iw = 1.0f / (w0 + w1 + w2); w0 *= iw; w1 *= iw; w2 *= iw;
#pragma unroll
        for (int j = 0; j < 16; ++j) y[j] = 0.f;
#pragma unroll
        for (int i = 0; i < 3; ++i) {
            const float wi = i == 0 ? w0 : (i == 1 ? w1 : w2);
            const v4u* op = (const v4u*)(opart + ((size_t)i * M + row) * ATTW + c0);
            const v4u a = op[0], b = op[1];
            float f[16] = {bflo(a.x), bfhi(a.x), bflo(a.y), bfhi(a.y), bflo(a.z), bfhi(a.z), bflo(a.w), bfhi(a.w), bflo(b.x), bfhi(b.x), bflo(b.y), bfhi(b.y), bflo(b.z), bfhi(b.z), bflo(b.w), bfhi(b.w)};
#pragma unroll
            for (int j = 0; j < 16; ++j) y[j] += wi * f[j];
        }
        float ss = 0.f;
#pragma unroll
        for (int j = 0; j < 16; ++j) ss += y[j] * y[j];
        const float rstd = 1.0f / sqrtf(wave_sum(ss) * (1.0f / ATTW) + EPS);
        const f32x4* g4 = (const f32x4*)(ga + c0);
        v4u o0, o1; const f32x4 ga0 = g4[0], ga1 = g4[1], ga2 = g4[2], ga3 = g4[3];
        o0.x = pk2(y[0] * rstd * ga0.x, y[1] * rstd * ga0.y); o0.y = pk2(y[2] * rstd * ga0.z, y[3] * rstd * ga0.w);
        o0.z = pk2(y[4] * rstd * ga1.x, y[5] * rstd * ga1.y); o0.w = pk2(y[6] * rstd * ga1.z, y[7] * rstd * ga1.w);
        o1.x = pk2(y[8] * rstd * ga2.x, y[9] * rstd * ga2.y); o1.y = pk2(y[10] * rstd * ga2.z, y[11] * rstd * ga2.w);
        o1.z = pk2(y[12] * rstd * ga3.x, y[13] * rstd * ga3.y); o1.w = pk2(y[14] * rstd * ga3.z, y[15] * rstd * ga3.w);
        v4u* cp = (v4u*)(cat + (size_t)row * DM + POOLW + c0); cp[0] = o0; cp[1] = o1;
    }
}

#define XB_TMO      128
#define XB_XCNT(j)  (256  + 64 * (j))
#define XB_XSUB(j)  (1280 + 64 * (j))
#define XB_XGEN(j)  (2304 + 64 * (j))
#define XB_TOP      3328
#define XB_TOPGEN   3392
#define XCD_BAR_WORDS 3456
#define XB_SPIN_CAP (1u << 18)

__device__ __forceinline__ unsigned xb_ld(unsigned* p)              { return __hip_atomic_load(p, __ATOMIC_RELAXED, __HIP_MEMORY_SCOPE_AGENT); }
__device__ __forceinline__ unsigned xb_add(unsigned* p, unsigned v) { return __hip_atomic_fetch_add(p, v, __ATOMIC_RELAXED, __HIP_MEMORY_SCOPE_AGENT); }
__device__ __forceinline__ unsigned xb_xcc_id() { return (unsigned)__builtin_amdgcn_s_getreg((3 << 11) | 20) & 0xFu; }
#define XB_SPIN(cond, bar) do { unsigned _sp = 0; while (cond) { __builtin_amdgcn_s_sleep(1); \
    if ((++_sp & 255u) == 0u) { if (xb_ld(&(bar)[XB_TMO])) break; if (_sp > XB_SPIN_CAP) { atomicAdd(&(bar)[XB_TMO], 1u); break; } } } } while (0)

struct XcdBarrier {
    unsigned* bar; unsigned x;
    volatile LAS unsigned* st;
};

__device__ __forceinline__ XcdBarrier xcd_barrier_post(unsigned* bar, volatile LAS unsigned* st) {
    XcdBarrier b; b.bar = bar; b.x = xb_xcc_id(); b.st = st;
    if (threadIdx.x == 0) (void)xb_add(&bar[XB_XCNT(b.x)], 1u);
    return b;
}
__device__ __forceinline__ void xcd_barrier_complete(unsigned* bar, unsigned x, unsigned& nloc, unsigned& nx) {
    const unsigned G = gridDim.x * gridDim.y * gridDim.z;
    unsigned sum, cnt, mine, sp = 0u;
    for (;;) {
        sum = 0u; cnt = 0u; mine = 0u;
#pragma unroll
        for (unsigned j = 0; j < 16; ++j) { const unsigned c = xb_ld(&bar[XB_XCNT(j)]); sum += c; cnt += (c > 0u) ? 1u : 0u; mine = (j == x) ? c : mine; }
        if (sum == G) break;
        __builtin_amdgcn_s_sleep(1);
        if ((++sp & 255u) == 0u) { if (xb_ld(&bar[XB_TMO])) break; if (sp > XB_SPIN_CAP) { atomicAdd(&bar[XB_TMO], 1u); break; } }
    }
    nloc = mine > 0u ? mine : 1u; nx = cnt > 0u ? cnt : 1u;
}

__device__ __forceinline__ void xcd_barrier(const XcdBarrier& b) {
    asm volatile("s_waitcnt vmcnt(0)" ::: "memory");
    __syncthreads();
    if (threadIdx.x == 0) {
        unsigned* bar = b.bar;
        __builtin_amdgcn_s_waitcnt(0);
        unsigned nloc = b.st[0], nx = b.st[1];
        if (nloc == 0u) { xcd_barrier_complete(bar, b.x, nloc, nx); b.st[0] = nloc; b.st[1] = nx; }
        const unsigned old = xb_add(&bar[XB_XSUB(b.x)], 1u);
        const unsigned gen = old / nloc;
        if (old + 1u == (gen + 1u) * nloc) {
            __builtin_amdgcn_fence(__ATOMIC_RELEASE, "agent");
            asm volatile("s_waitcnt vmcnt(0)" ::: "memory");
            const unsigned og = xb_add(&bar[XB_TOP], 1u);
            const unsigned tg = og / nx;
            if (og + 1u == (tg + 1u) * nx) xb_add(&bar[XB_TOPGEN], 1u);
            else XB_SPIN(xb_ld(&bar[XB_TOPGEN]) == tg, bar);
            __builtin_amdgcn_fence(__ATOMIC_ACQUIRE, "agent");
            xb_add(&bar[XB_XGEN(b.x)], 1u);
            asm volatile("s_waitcnt vmcnt(0)" ::: "memory");
        } else {
            XB_SPIN(xb_ld(&bar[XB_XGEN(b.x)]) == gen, bar);
            __builtin_amdgcn_fence(__ATOMIC_ACQUIRE, "agent");
            asm volatile("s_waitcnt vmcnt(0)" ::: "memory");
        }
    }
    __syncthreads();
}

#ifndef MK_N_LAUNCHES
#define MK_N_LAUNCHES 1
#endif
constexpr int N_PHASES = 9;
#ifndef PROBE_SYNC
#define PROBE_SYNC 0
#endif
#ifndef PROBE_GEMM
#define PROBE_GEMM -1
#endif
#ifndef PROBE_VAR
#define PROBE_VAR 0
#endif
#ifndef PROBE_REP
#define PROBE_REP -1
#endif
#define REP(k) for (int rep_ = 0; rep_ < ((PROBE_REP) == (k) ? 2 : 1); ++rep_)
struct Args { const float* in[12]; float* out; unsigned char* ws; int ph_lo, ph_hi; };

__global__ void __launch_bounds__(NTHREADS, 2) fwd_mega(Args args) {
    extern __shared__ __attribute__((aligned(16))) unsigned char lds_raw[];
    LAS unsigned char* lds = (LAS unsigned char*)lds_raw;
    const int tid = threadIdx.x, lane = tid & 63, wave = __builtin_amdgcn_readfirstlane(tid >> 6);
    const int G = gridDim.x, bx = blockIdx.x;
    const int gw = bx * NWAVES + wave, NGW = G * NWAVES;
    unsigned char* ws = args.ws;
    const float* x = args.in[0]; const float* g_mix = args.in[1]; const float* w_in = args.in[2]; const float* pool_w = args.in[3]; const float* pool_scale = args.in[4];
    const float* g_pool = args.in[5]; const float* g_attn = args.in[6]; const float* w_out = args.in[7]; const float* g_mlp = args.in[8]; const float* w_up = args.in[9];
    const float* w_down = args.in[10]; const float* g_fin = args.in[11];
    float* out = args.out;
    bf16* WCAT = (bf16*)(ws + WS_WCAT); bf16* WOUT = (bf16*)(ws + WS_WOUT); bf16* WUP = (bf16*)(ws + WS_WUP); bf16* WDN = (bf16*)(ws + WS_WDN);
    bf16* XN = (bf16*)(ws + WS_XN); bf16* PROJ = (bf16*)(ws + WS_PROJ); bf16* CAT = (bf16*)(ws + WS_CAT); bf16* OPART = (bf16*)(ws + WS_OPART);
    f32x2* ML = (f32x2*)(ws + WS_ML); bf16* HB = (bf16*)(ws + WS_H); float* SSQ = (float*)(ws + WS_SSQ);
    const int lo = args.ph_lo, hi = args.ph_hi;
#define IN(k) (lo <= (k) && (k) < hi)
#define SEAM(k) do { if (IN(k) && IN((k) + 1)) { if ((k) == 0) { cg::this_grid().sync(); xbar = xcd_barrier_post((unsigned*)(ws + WS_BAR), (volatile LAS unsigned*)(lds + RING_BYTES + 320)); } else xcd_barrier(xbar); } } while (0)
    XcdBarrier xbar; xbar.bar = (unsigned*)(ws + WS_BAR); xbar.x = 0; xbar.st = (volatile LAS unsigned*)(lds + RING_BYTES + 320);
    if (lo == 0 && hi == N_PHASES) {
        if (bx == 0) for (int i = tid; i < XCD_BAR_WORDS; i += NTHREADS) __hip_atomic_store((unsigned*)(ws + WS_BAR) + i, 0u, __ATOMIC_RELAXED, __HIP_MEMORY_SCOPE_AGENT);
        if (tid < 2) ((volatile LAS unsigned*)(lds + RING_BYTES + 320))[tid] = 0u;
        __syncthreads();
    }

    if (IN(0)) REP(0) {
        const int pv0 = rep_ == 0 ? 0 : PROBE_VAR;
        for (int i = bx * NTHREADS + tid; i < 2 * M; i += G * NTHREADS) SSQ[i] = 0.f;
        if (pv0 == 0 || pv0 == 1)
        {
            LAS float* wt = (LAS float*)lds;
            const int f = tid & 255, kh = tid >> 8;
            for (int tile = bx; tile < 512; tile += G) {
                const int g = tile >> 7, k0 = (tile & 127) * 16;
#pragma unroll
                for (int j = 0; j < 8; ++j) { const int idx = tid + 512 * j, kk = idx >> 8, c = idx & 255; wt[kk * 256 + c] = w_in[(size_t)(k0 + kk) * INW + g * 256 + c]; }
                __syncthreads();
                float acc[8];
#pragma unroll
                for (int kk = 0; kk < 8; ++kk) acc[kk] = 0.f;
                const float* pw = pool_w + (size_t)g * 65536 + f;
                for (int cb = 0; cb < 256; cb += 32) {
                    float pv_[32];
#pragma unroll
                    for (int i = 0; i < 32; ++i) pv_[i] = pw[(cb + i) * 256];
#pragma unroll
                    for (int i = 0; i < 32; i += 4)
#pragma unroll
                        for (int kk = 0; kk < 8; ++kk) { const f32x4 v = *(const LAS f32x4*)(wt + (8 * kh + kk) * 256 + cb + i); acc[kk] += (pv_[i] * v.x + pv_[i + 1] * v.y) + (pv_[i + 2] * v.z + pv_[i + 3] * v.w); }
                }
                const float sc = pool_scale[g * 256 + f];
                v4u o; o.x = pk2(acc[0] * sc, acc[1] * sc); o.y = pk2(acc[2] * sc, acc[3] * sc); o.z = pk2(acc[4] * sc, acc[5] * sc); o.w = pk2(acc[6] * sc, acc[7] * sc);
                *(v4u*)(WCAT + (size_t)(g * 256 + f) * DM + k0 + 8 * kh) = o;
                __syncthreads();
            }
        }
        if (pv0 == 0 || pv0 == 2)
        {
            LAS float* scr = (LAS float*)(lds + wave * 16384);
            constexpr int I_QKV = (DM / 64) * (3 * ATTW / 32), I_O = (DM / 64) * (DM / 32), I_U = (DM / 64) * (DFF / 32), I_D = (DFF / 64) * (DM / 32);
            for (int it = gw; it < I_QKV + I_O + I_U + I_D; it += NGW) {
                int r = it;
                if (r < I_QKV) { p0_transpose_item(w_in + POOLW, INW, DM, 3 * ATTW, WCAT, POOLW, ATTW, QSCALE, nullptr, scr, r, lane); continue; } r -= I_QKV;
                if (r < I_O) { p0_transpose_item(w_out, DM, DM, DM, WOUT, 0, 0, 1.f, nullptr, scr, r, lane); continue; } r -= I_O;
                if (r < I_U) { p0_transpose_item(w_up, DFF, DM, DFF, WUP, 0, 0, 1.f, g_mlp, scr, r, lane); continue; } r -= I_U;
                p0_transpose_item(w_down, DM, DFF, DM, WDN, 0, 0, 1.f, nullptr, scr, r, lane);
            }
        }
        if (pv0 == 0 || pv0 == 3)
        for (int m = gw; m < M; m += NGW) rms_row<true>(x + (size_t)m * DM, g_mix, XN + (size_t)m * DM, lane);
    }
    SEAM(0);
    for (int xs_ = 0; xs_ < PROBE_SYNC; ++xs_) cg::this_grid().sync();
    if (IN(1)) REP(1) {
        __syncthreads();
        pg8::Gemm g{XN, WCAT, M, INW, DM}; pg8::RepOrder<(PROBE_GEMM == 1 ? 2 : 1)> S; S.init(M, INW, G, bx);
        pg8::EpiBf16Act<0> E{PROJ, PP, nullptr, 0.f, 0.f};
        pg8::gemm_phase<pg8::EpiBf16Act<0>, pg8::RepOrder<(PROBE_GEMM == 1 ? 2 : 1)>, PG8_ALIGN, PG8_SP2>(lds, g, S, E);
    }
    SEAM(1);
    if (IN(2)) REP(2) {
        for (int u = bx; u < 768; u += G) attn_wg_unit(PROJ, OPART, ML, u, (LAS char*)lds, wave, lane, rep_ == 0 ? 0 : PROBE_VAR);
        asm volatile("s_waitcnt vmcnt(0)" ::: "memory");
        __syncthreads();
    }
    SEAM(2);
    if (IN(3)) REP(3) {
        for (int m = gw; m < M; m += NGW) merge_row(PROJ, OPART, ML, g_pool, g_attn, CAT, m, lane);
    }
    SEAM(3);
    if (IN(4)) REP(4) {
        __syncthreads();
        pg8::Gemm g{CAT, WOUT, M, DM, DM}; pg8::RepOrder<(PROBE_GEMM == 4 ? 2 : 1)> S; S.init(M, DM, G, bx);
        pg8::EpiResBf16<false> E{x, XN, DM, SSQ};
        pg8::gemm_phase<pg8::EpiResBf16<false>, pg8::RepOrder<(PROBE_GEMM == 4 ? 2 : 1)>, PG8_ALIGN, PG8_SP2>(lds, g, S, E);
    }
    SEAM(4);
    if (IN(6)) REP(6) {
        __syncthreads();
        pg8::Gemm g{XN, WUP, M, DFF, DM}; pg8::RepOrder<(PROBE_GEMM == 6 ? 2 : 1)> S; S.init(M, DFF, G, bx);
        pg8::EpiBf16Act<2> E{HB, DFF, SSQ, 1.0f / DM, EPS};
        pg8::gemm_phase<pg8::EpiBf16Act<2>, pg8::RepOrder<(PROBE_GEMM == 6 ? 2 : 1)>, PG8_ALIGN, PG8_SP2>(lds, g, S, E);
    }
    SEAM(6);
    if (IN(7)) REP(7) {
        __syncthreads();
        pg8::Gemm g{HB, WDN, M, DM, DFF}; pg8::StaticOrder S; S.init(M, DM, G, bx);
        pg8::EpiResBf16<true> E{XN, XN, DM, SSQ + M};
        pg8::gemm_phase<pg8::EpiResBf16<true>, pg8::StaticOrder, PG8_ALIGN, PG8_SP2>(lds, g, S, E);
    }
    SEAM(7);
    if (IN(8)) REP(8) {
        for (int m = gw; m < M; m += NGW) {
            const float rstd = 1.0f / sqrtf(SSQ[M + m] * (1.0f / DM) + EPS);
            const v4u* xr = (const v4u*)(XN + (size_t)m * DM) + lane; const f32x4* gr = (const f32x4*)g_fin + 2 * lane; f32x4* orow = (f32x4*)(out + (size_t)m * DM) + 2 * lane;
            v4u w[4];
#pragma unroll
            for (int j = 0; j < 4; ++j) w[j] = xr[64 * j];
#pragma unroll
            for (int j = 0; j < 4; ++j) { const f32x4 g0 = gr[128 * j], g1 = gr[128 * j + 1];
                orow[128 * j] = (f32x4){bflo(w[j].x) * rstd * g0.x, bfhi(w[j].x) * rstd * g0.y, bflo(w[j].y) * rstd * g0.z, bfhi(w[j].y) * rstd * g0.w};
                orow[128 * j + 1] = (f32x4){bflo(w[j].z) * rstd * g1.x, bfhi(w[j].z) * rstd * g1.y, bflo(w[j].w) * rstd * g1.z, bfhi(w[j].w) * rstd * g1.w}; }
        }
    }
#undef IN
#undef SEAM
}

extern "C" void kernel_launch(void* const* d_in, const int* in_sizes, int n_in, void* d_out, int out_size, void* d_ws, size_t ws_size, hipStream_t stream) {
    static int grid = 0;
    if (grid == 0) {
        if (n_in != 12 || in_sizes[0] != M * DM || out_size != M * DM || ws_size < WS_END) { fprintf(stderr, "kernel_launch: unexpected shapes (n_in %d, in0 %d, out %d, ws %zu); nothing launched\n", n_in, n_in > 0 ? in_sizes[0] : -1, out_size, ws_size); grid = -1; return; }
        int dev = 0, cus = 0, per_cu = 0;
        if (hipGetDevice(&dev) != hipSuccess || hipDeviceGetAttribute(&cus, hipDeviceAttributeMultiprocessorCount, dev) != hipSuccess) { fprintf(stderr, "kernel_launch: device query failed\n"); grid = -1; return; }
        if (hipFuncSetAttribute((const void*)fwd_mega, hipFuncAttributeMaxDynamicSharedMemorySize, LDS_BYTES) != hipSuccess) { fprintf(stderr, "kernel_launch: hipFuncSetAttribute failed\n"); grid = -1; return; }
        if (hipOccupancyMaxActiveBlocksPerMultiprocessor(&per_cu, (const void*)fwd_mega, NTHREADS, LDS_BYTES) != hipSuccess || per_cu < 1) { fprintf(stderr, "kernel_launch: occupancy query gave %d\n", per_cu); per_cu = 1; }
        (void)hipGetLastError();
        grid = cus * per_cu;
    }
    if (grid < 0) return;
    Args a{};
    for (int i = 0; i < 12; ++i) a.in[i] = (const float*)d_in[i];
    a.out = (float*)d_out; a.ws = (unsigned char*)d_ws;
#if MK_N_LAUNCHES == 1
    a.ph_lo = 0; a.ph_hi = N_PHASES;
    void* kargs[] = {&a};
    hipError_t e = hipLaunchCooperativeKernel((const void*)fwd_mega, dim3(grid), dim3(NTHREADS), kargs, LDS_BYTES, stream);
    if (e != hipSuccess) fprintf(stderr, "kernel_launch: cooperative launch failed: %s (grid %d)\n", hipGetErrorString(e), grid);
#else
    for (int ph = 0; ph < N_PHASES; ++ph) {
        a.ph_lo = ph; a.ph_hi = ph + 1;
        hipLaunchKernelGGL(fwd_mega, dim3(grid), dim3(NTHREADS), LDS_BYTES, stream, a);
    }
#endif
}
```

```cpp
#include <hip/hip_runtime.h>
#include <hip/hip_cooperative_groups.h>
#include <cstdio>
#include <cstdint>
#include <cmath>
namespace cg = cooperative_groups;
namespace pg8 {
#define PG8_LAS __attribute__((address_space(3)))
typedef unsigned short bf16_t;
typedef short bf16x8 __attribute__((ext_vector_type(8)));
typedef float f32x4 __attribute__((ext_vector_type(4)));
typedef unsigned u32x4 __attribute__((ext_vector_type(4)));
constexpr int BM = 256, BK = 64, HALF = 128, HTB = HALF * BK * 2  , STAGE_BYTES = 8 * HTB, NXCD = 8, WGM = 8;

__host__ __device__ __forceinline__ int lds_byte(int r, int c) { const int st = (r >> 4) * 2 + (c >> 5), rr = r & 15, cc = c & 31, ob = rr * 64 + cc * 2; return st * 1024 + (ob ^ (((ob >> 9) & 1) << 5)); }
__host__ __device__ __forceinline__ void stage_rc(int b, int& R, int& C) { const int st = b / 1024, sb = b % 1024, swz = sb ^ (((sb >> 9) & 1) << 5); R = (st >> 1) * 16 + swz / 64; C = (st & 1) * 32 + (swz % 64) / 2; }
__host__ __device__ __forceinline__ int perm32(int rho) { const int n = rho >> 4, i = rho & 15; return 8 * (i >> 2) + 4 * n + (i & 3); }

struct Unit { int pm, pn; };
struct Gemm { const bf16_t* A; const bf16_t* Bt; int M, N, K; };

struct StaticOrder {
    int nM, nN, nwg, G, c;
    __host__ __device__ void init(int M, int N, int G_, int c_) { nM = M / BM; nN = N / BM; nwg = nM * nN; G = G_; c = c_; }
    __host__ __device__ bool next(int i, Unit& u) const {
        const long L = (long)i * G + c; if (L >= nwg) return false;
        int wgid = (int)L; { const int q = nwg / NXCD, r = nwg % NXCD, xcd = wgid % NXCD, off = wgid / NXCD; wgid = (xcd < r ? xcd * (q + 1) : r * (q + 1) + (xcd - r) * q) + off; }
        const int nig = WGM * nN, gid = wgid / nig, fm = gid * WGM, gsz = (nM - fm) < WGM ? (nM - fm) : WGM;
        u.pm = fm + ((wgid % nig) % gsz); u.pn = (wgid % nig) / gsz; return true;
    }
    __device__ __forceinline__ void a_ready(const Unit&) const {}
    __device__ __forceinline__ void done(const Unit&) const {}
};

__device__ __forceinline__ unsigned cvt_pk_bf16(float lo, float hi) { unsigned r; asm volatile("v_cvt_pk_bf16_f32 %0, %1, %2" : "=v"(r) : "v"(lo), "v"(hi)); return r; }
typedef float f32x2 __attribute__((ext_vector_type(2)));
__device__ __forceinline__ f32x2 gelu_pk(f32x2 v) {
    const f32x2 av = __builtin_elementwise_abs(v), d = av * 0.2316418882f + 1.0f;
    f32x2 t; t.x = __builtin_amdgcn_rcpf(d.x); t.y = __builtin_amdgcn_rcpf(d.y);
    f32x2 q = t * 0.5307027145f + (-0.7265760135f); q = q * t + 0.7107068705f; q = q * t + (-0.142248368f); q = q * t + 0.127414796f; q = q * t;
    const f32x2 s = (v * v) * (-0.72134752044f);
    f32x2 e; e.x = __builtin_amdgcn_exp2f(s.x); e.y = __builtin_amdgcn_exp2f(s.y);
    const f32x2 m = v * (q * e), r = v - m;
    f32x2 o; o.x = v.x < 0.f ? m.x : r.x; o.y = v.y < 0.f ? m.y : r.y; return o;
}

template <int ACT  > struct EpiBf16 {
    static constexpr bool PERM = true, AFTER_DRAIN = false; static_assert(ACT == 0 || ACT == 1, "EpiBf16: ACT is 0 (none) or 1 (gelu_pk)");
    bf16_t* O; int ldc; const float* bias; int split_cols; size_t split_stride; float scale0;
    __device__ __forceinline__ void operator()(const f32x4 (&acc)[2][2][4][2], const Unit& u, int wr, int wc, int fr, int fq) const {
        const int row0 = u.pm * BM + wr * 64 + fr; int colt = u.pn * BM; bf16_t* base = O;
        float sc = 1.f; if (split_cols) { const int t = colt / split_cols; base += (size_t)t * split_stride; colt -= t * split_cols; if (t == 0) sc = scale0; }
        const int col0 = colt + wc * 32 + 8 * fq, bcol0 = u.pn * BM + wc * 32 + 8 * fq;
        f32x4 bv[2][2];
#pragma unroll
        for (int bj = 0; bj < 2; ++bj)
#pragma unroll
            for (int n = 0; n < 2; ++n) bv[bj][n] = bias ? *(const f32x4*)(bias + bcol0 + bj * HALF + 4 * n) : (f32x4){0.f, 0.f, 0.f, 0.f};
#pragma unroll
        for (int ai = 0; ai < 2; ++ai)
#pragma unroll
            for (int m = 0; m < 4; ++m) { bf16_t* rowp = base + (size_t)(row0 + ai * HALF + m * 16) * ldc + col0;
#pragma unroll
                for (int bj = 0; bj < 2; ++bj) { f32x4 v0 = acc[ai][bj][m][0] + bv[bj][0], v1 = acc[ai][bj][m][1] + bv[bj][1];
                    if (ACT == 1) { f32x2 a = gelu_pk((f32x2){v0[0], v0[1]}), b = gelu_pk((f32x2){v0[2], v0[3]}), c = gelu_pk((f32x2){v1[0], v1[1]}), d = gelu_pk((f32x2){v1[2], v1[3]});
                        v0 = (f32x4){a.x, a.y, b.x, b.y}; v1 = (f32x4){c.x, c.y, d.x, d.y}; }
                    v0 = v0 * sc; v1 = v1 * sc; u32x4 w; w.x = cvt_pk_bf16(v0[0], v0[1]); w.y = cvt_pk_bf16(v0[2], v0[3]); w.z = cvt_pk_bf16(v1[0], v1[1]); w.w = cvt_pk_bf16(v1[2], v1[3]);
                    *(u32x4*)(rowp + bj * HALF) = w; } }
    }
};
template <class Epi, class Sched, bool ALIGN_EPI = false, bool SP2 = false>
__device__ __forceinline__ void gemm_phase(PG8_LAS unsigned char* lds, const Gemm g, const Sched& S, const Epi& E) {
    const int tid = threadIdx.x, wid = __builtin_amdgcn_readfirstlane(tid >> 6), lane = tid & 63, wr = wid >> 2, wc = wid & 3, fr = lane & 15, fq = lane >> 4;
    const int K = g.K, nt = K / BK;
    unsigned voffA[2], voffB[2];
#pragma unroll
    for (int i = 0; i < 2; ++i) { int R, C; stage_rc(tid * 16 + i * 8192, R, C); const int Rb = Epi::PERM ? ((R & ~31) + perm32(R & 31)) : R;
        voffA[i] = (unsigned)(R * K + C) * 2u; voffB[i] = (unsigned)(Rb * K + C) * 2u; }
    const size_t kstep = (size_t)(BK * 2);
    const size_t hstep = (size_t)HALF * K * 2;
    const size_t tstep = 2 * hstep;
    const unsigned ldsw = (unsigned)wid * 1024u;
    const int aoff = lds_byte(wr * 64 + fr, fq * 8), boff = lds_byte(wc * 32 + fr, fq * 8);
#define PG8_SA(b, h) (((b) * 2 + (h)) * HTB)
#define PG8_SB(b, h) ((4 + (b) * 2 + (h)) * HTB)
#define PG8_STAGE(bufoff, gbase, voff) do { _Pragma("unroll") for (int _i = 0; _i < 2; ++_i) \
        __builtin_amdgcn_global_load_lds((const unsigned*)((const char*)(gbase) + (voff)[_i]), (PG8_LAS unsigned*)(lds + (bufoff) + ldsw + _i * 8192), 16, 0, 0); } while (0)
#define PG8_LDA(dst, b, h) do { _Pragma("unroll") for (int m = 0; m < 4; ++m) _Pragma("unroll") for (int k = 0; k < 2; ++k) dst[m][k] = *(const PG8_LAS bf16x8*)(lds + PG8_SA(b, h) + aoff + m * 2048 + k * 1024); } while (0)
#define PG8_LDB(dst, b, h) do { _Pragma("unroll") for (int n = 0; n < 2; ++n) _Pragma("unroll") for (int k = 0; k < 2; ++k) dst[n][k] = *(const PG8_LAS bf16x8*)(lds + PG8_SB(b, h) + boff + n * 2048 + k * 1024); } while (0)
#define PG8_MMA(ai, bj, At, Bt) do { __builtin_amdgcn_s_setprio(1); _Pragma("unroll") for (int m = 0; m < 4; ++m) _Pragma("unroll") for (int n = 0; n < 2; ++n) _Pragma("unroll") for (int k = 0; k < 2; ++k) \
        acc[ai][bj][m][n] = __builtin_amdgcn_mfma_f32_16x16x32_bf16(Bt[n][k], At[m][k], acc[ai][bj][m][n], 0, 0, 0); __builtin_amdgcn_s_setprio(0); } while (0)
#define PG8_WAIT_V(n) asm volatile("s_waitcnt vmcnt(" #n ")" ::: "memory")
#define PG8_WAIT_L(n) asm volatile("s_waitcnt lgkmcnt(" #n ")" ::: "memory")
#define PG8_BAR __builtin_amdgcn_s_barrier()
#define PG8_SCHED __builtin_amdgcn_sched_barrier(0)
    Unit cur, nxt; int ui = 0;
    if (!S.next(0, cur)) return;
    f32x4 acc[2][2][4][2];
#pragma unroll
    for (int a = 0; a < 2; ++a)
#pragma unroll
        for (int b = 0; b < 2; ++b)
#pragma unroll
            for (int m = 0; m < 4; ++m)
#pragma unroll
                for (int n = 0; n < 2; ++n) acc[a][b][m][n] = (f32x4){0.f, 0.f, 0.f, 0.f};
    bf16x8 At[4][2], B0[2][2], B1[2][2];
    const char* cA = (const char*)g.A + (size_t)cur.pm * tstep; const char* cB = (const char*)g.Bt + (size_t)cur.pn * tstep;
    S.a_ready(cur);
    if constexpr (SP2) {
        PG8_STAGE(PG8_SB(0, 0), cB, voffB); PG8_STAGE(PG8_SB(0, 1), cB + hstep, voffB); PG8_STAGE(PG8_SA(0, 0), cA, voffA); PG8_STAGE(PG8_SA(0, 1), cA + hstep, voffA);
        if (wr == 1) PG8_BAR;
        PG8_WAIT_V(2); PG8_BAR;
        PG8_STAGE(PG8_SB(1, 0), cB + kstep, voffB); PG8_STAGE(PG8_SA(1, 0), cA + kstep, voffA); PG8_STAGE(PG8_SB(1, 1), cB + hstep + kstep, voffB);
        PG8_WAIT_V(6); PG8_BAR;
    } else {
        PG8_STAGE(PG8_SB(0, 0), cB, voffB); PG8_STAGE(PG8_SA(0, 0), cA, voffA); PG8_STAGE(PG8_SB(0, 1), cB + hstep, voffB); PG8_STAGE(PG8_SA(0, 1), cA + hstep, voffA);
        if (wr == 1) PG8_BAR;
        PG8_WAIT_V(4); PG8_BAR;
        PG8_STAGE(PG8_SB(1, 0), cB + kstep, voffB); PG8_STAGE(PG8_SA(1, 0), cA + kstep, voffA); PG8_STAGE(PG8_SB(1, 1), cB + hstep + kstep, voffB);
        PG8_WAIT_V(6); PG8_BAR;
    }
    for (;;) {
        const bool has_next = S.next(ui + 1, nxt);
        const char* nA = has_next ? (const char*)g.A + (size_t)nxt.pm * tstep : cA; const char* nB = has_next ? (const char*)g.Bt + (size_t)nxt.pn * tstep : cB;
        for (int t = 0; t < nt; t += 2) {
            const bool last = (t == nt - 2);
            const char* a1 = cA + (size_t)(t + 1) * kstep;
            const char* a2 = last ? nA : cA + (size_t)(t + 2) * kstep; const char* b2 = last ? nB : cB + (size_t)(t + 2) * kstep;
            const char* a3 = a2 + kstep; const char* b3 = b2 + kstep;
            if (last && has_next) S.a_ready(nxt);
            if constexpr (SP2) {
            PG8_LDB(B0, 0, 0); PG8_LDB(B1, 0, 1); PG8_SCHED; PG8_LDA(At, 0, 0); PG8_STAGE(PG8_SA(1, 1), a1 + hstep, voffA);
            PG8_WAIT_V(8); PG8_WAIT_L(0); PG8_BAR; PG8_MMA(0, 0, At, B0); PG8_MMA(0, 1, At, B1); PG8_BAR; PG8_SCHED;
            PG8_LDA(At, 0, 1); PG8_STAGE(PG8_SB(0, 0), b2, voffB); PG8_STAGE(PG8_SB(0, 1), b2 + hstep, voffB); PG8_STAGE(PG8_SA(0, 0), a2, voffA);
            PG8_WAIT_V(8); PG8_WAIT_L(0); PG8_BAR; PG8_MMA(1, 0, At, B0); PG8_MMA(1, 1, At, B1); PG8_BAR; PG8_SCHED;
            PG8_LDB(B0, 1, 0); PG8_LDB(B1, 1, 1); PG8_SCHED; PG8_LDA(At, 1, 0); PG8_STAGE(PG8_SA(0, 1), a2 + hstep, voffA);
            PG8_WAIT_V(8); PG8_WAIT_L(0); PG8_BAR; PG8_MMA(0, 0, At, B0); PG8_MMA(0, 1, At, B1); PG8_BAR; PG8_SCHED;
            PG8_LDA(At, 1, 1); PG8_STAGE(PG8_SB(1, 0), b3, voffB); PG8_STAGE(PG8_SB(1, 1), b3 + hstep, voffB); PG8_STAGE(PG8_SA(1, 0), a3, voffA);
            PG8_WAIT_V(8); PG8_WAIT_L(0); PG8_BAR; PG8_MMA(1, 0, At, B0); PG8_MMA(1, 1, At, B1); PG8_BAR; PG8_SCHED;
            } else {
            PG8_LDB(B0, 0, 0); PG8_SCHED; PG8_LDA(At, 0, 0); PG8_STAGE(PG8_SA(1, 1), a1 + hstep, voffA);
            PG8_WAIT_L(8); PG8_BAR; PG8_WAIT_L(0); PG8_MMA(0, 0, At, B0); PG8_BAR; PG8_SCHED;
            PG8_LDB(B1, 0, 1); PG8_STAGE(PG8_SB(0, 0), b2, voffB);
            PG8_BAR; PG8_WAIT_L(0); PG8_MMA(0, 1, At, B1); PG8_BAR;
            PG8_LDA(At, 0, 1); PG8_STAGE(PG8_SA(0, 0), a2, voffA);
            PG8_BAR; PG8_WAIT_L(0); PG8_MMA(1, 0, At, B0); PG8_BAR; PG8_SCHED;
            PG8_STAGE(PG8_SB(0, 1), b2 + hstep, voffB);
            PG8_WAIT_V(6); PG8_BAR; PG8_MMA(1, 1, At, B1); PG8_BAR;
            PG8_LDB(B0, 1, 0); PG8_SCHED; PG8_LDA(At, 1, 0); PG8_STAGE(PG8_SA(0, 1), a2 + hstep, voffA);
            PG8_WAIT_L(8); PG8_BAR; PG8_WAIT_L(0); PG8_MMA(0, 0, At, B0); PG8_BAR; PG8_SCHED;
            PG8_LDB(B1, 1, 1); PG8_STAGE(PG8_SB(1, 0), b3, voffB);
            PG8_BAR; PG8_WAIT_L(0); PG8_MMA(0, 1, At, B1); PG8_BAR;
            PG8_LDA(At, 1, 1); PG8_STAGE(PG8_SA(1, 0), a3, voffA);
            PG8_BAR; PG8_WAIT_L(0); PG8_MMA(1, 0, At, B0); PG8_BAR; PG8_SCHED;
            PG8_STAGE(PG8_SB(1, 1), b3 + hstep, voffB);
            PG8_WAIT_V(6); PG8_BAR; PG8_MMA(1, 1, At, B1); PG8_BAR;
            }
        }
        if constexpr (ALIGN_EPI) { if (wr == 0) PG8_BAR; }
        if constexpr (!Epi::AFTER_DRAIN) { E(acc, cur, wr, wc, fr, fq); S.done(cur); }
        if (!has_next) break;
#pragma unroll
        for (int a = 0; a < 2; ++a)
#pragma unroll
            for (int b = 0; b < 2; ++b)
#pragma unroll
                for (int m = 0; m < 4; ++m)
#pragma unroll
                    for (int n = 0; n < 2; ++n) acc[a][b][m][n] = (f32x4){0.f, 0.f, 0.f, 0.f};
        cur = nxt; cA = nA; cB = nB; ++ui;
        if constexpr (ALIGN_EPI) { if (wr == 1) PG8_BAR; }
    }
    PG8_WAIT_V(0);
    if constexpr (!ALIGN_EPI) { if (wr == 0) PG8_BAR; }
    PG8_BAR;
    if constexpr (Epi::AFTER_DRAIN) { E.fused(acc, cur, wr, wc, fr, fq, lds, wid, lane); S.done(cur); }
#undef PG8_SA
#undef PG8_SB
#undef PG8_STAGE
#undef PG8_LDA
#undef PG8_LDB
#undef PG8_MMA
#undef PG8_WAIT_V
#undef PG8_WAIT_L
#undef PG8_BAR
#undef PG8_SCHED
}
}
#define PG8_SP2 true
#define PG8_ALIGN true

namespace pg8 {
template <int ACT  > struct EpiBf16Act {
    static constexpr bool PERM = true, AFTER_DRAIN = false;
    bf16_t* O; int ldc; const float* ssq; float inv_n, eps;
    __device__ __forceinline__ void operator()(const f32x4 (&acc)[2][2][4][2], const Unit& u, int wr, int wc, int fr, int fq) const {
        const int row0 = u.pm * BM + wr * 64 + fr; const int col0 = u.pn * BM + wc * 32 + 8 * fq;
#pragma unroll
        for (int ai = 0; ai < 2; ++ai)
#pragma unroll
            for (int m = 0; m < 4; ++m) { bf16_t* rowp = O + (size_t)(row0 + ai * HALF + m * 16) * ldc + col0;
                const float r2 = (ACT == 2 && ssq) ? 1.0f / (ssq[row0 + ai * HALF + m * 16] * inv_n + eps) : 1.0f;
#pragma unroll
                for (int bj = 0; bj < 2; ++bj) { f32x4 v0 = acc[ai][bj][m][0], v1 = acc[ai][bj][m][1];
                    if (ACT == 2) {
#pragma unroll
                        for (int e = 0; e < 4; ++e) { const float a = fmaxf(v0[e], 0.f), b = fmaxf(v1[e], 0.f); v0[e] = a * a * r2; v1[e] = b * b * r2; } }
                    u32x4 w; w.x = cvt_pk_bf16(v0[0], v0[1]); w.y = cvt_pk_bf16(v0[2], v0[3]); w.z = cvt_pk_bf16(v1[0], v1[1]); w.w = cvt_pk_bf16(v1[2], v1[3]);
                    *(u32x4*)(rowp + bj * HALF) = w; } }
    }
};
template <bool BASE_BF16> struct EpiResBf16 {
    static constexpr bool PERM = true, AFTER_DRAIN = false;
    const void* base; bf16_t* xb; int ldc; float* ssq;
    __device__ __forceinline__ void operator()(const f32x4 (&acc)[2][2][4][2], const Unit& u, int wr, int wc, int fr, int fq) const {
        const int row0 = u.pm * BM + wr * 64 + fr; const int col0 = u.pn * BM + wc * 32 + 8 * fq;
#pragma unroll
        for (int ai = 0; ai < 2; ++ai)
#pragma unroll
            for (int m = 0; m < 4; ++m) { const int row = row0 + ai * HALF + m * 16; const size_t off = (size_t)row * ldc + col0; float sq = 0.f;
#pragma unroll
                for (int bj = 0; bj < 2; ++bj) {
                    f32x4 b0, b1;
                    if (BASE_BF16) { const u32x4 w = *(const u32x4*)((const bf16_t*)base + off + bj * HALF);
                        b0 = (f32x4){__builtin_bit_cast(float, w.x << 16), __builtin_bit_cast(float, w.x & 0xffff0000u), __builtin_bit_cast(float, w.y << 16), __builtin_bit_cast(float, w.y & 0xffff0000u)};
                        b1 = (f32x4){__builtin_bit_cast(float, w.z << 16), __builtin_bit_cast(float, w.z & 0xffff0000u), __builtin_bit_cast(float, w.w << 16), __builtin_bit_cast(float, w.w & 0xffff0000u)}; }
                    else { b0 = *(const f32x4*)((const float*)base + off + bj * HALF); b1 = *(const f32x4*)((const float*)base + off + bj * HALF + 4); }
                    const f32x4 v0 = b0 + acc[ai][bj][m][0], v1 = b1 + acc[ai][bj][m][1];
                    sq += (v0[0] * v0[0] + v0[1] * v0[1]) + (v0[2] * v0[2] + v0[3] * v0[3]) + (v1[0] * v1[0] + v1[1] * v1[1]) + (v1[2] * v1[2] + v1[3] * v1[3]);
                    u32x4 w; w.x = cvt_pk_bf16(v0[0], v0[1]); w.y = cvt_pk_bf16(v0[2], v0[3]); w.z = cvt_pk_bf16(v1[0], v1[1]); w.w = cvt_pk_bf16(v1[2], v1[3]);
                    *(u32x4*)(xb + off + bj * HALF) = w; }
                sq += __shfl_xor(sq, 16); sq += __shfl_xor(sq, 32); if (fq == 0) atomicAdd(ssq + row, sq); }
    }
};
}

namespace pg8 {
template <int REPN> struct RepOrder {
    StaticOrder b;
    __host__ __device__ void init(int M, int N, int G_, int c_) { b.init(M, N, G_, c_); }
    __host__ __device__ bool next(int i, Unit& u) const { return b.next(i / REPN, u); }
    __device__ __forceinline__ void a_ready(const Unit&) const {}
    __device__ __forceinline__ void done(const Unit&) const {}
};
}
constexpr int BATCH = 2, SEQ = 16384, DM = 2048, M = BATCH * SEQ;
constexpr int POOLW = 1024, ATTW = 1024, NHEAD = 8, HD = 128, INW = 4096, DFF = 8192;
constexpr int PP = INW + 136;
constexpr float EPS = 1e-6f;
constexpr float QSCALE = 0.08838834764831845f * 1.4426950408889634f;
constexpr float LOG2E = 1.4426950408889634f;
constexpr int NWAVES = 8, NTHREADS = 512;

constexpr size_t MiB = 1u << 20;
constexpr size_t WS_BAR = 16384;
constexpr size_t WS_SSQ = 1 * MiB;
constexpr size_t WS_WCAT = 2 * MiB;
constexpr size_t WS_WOUT = 18 * MiB;
constexpr size_t WS_WUP = 26 * MiB;
constexpr size_t WS_WDN = 58 * MiB;
constexpr size_t WS_XN = 96 * MiB;
constexpr size_t WS_PROJ = 224 * MiB;
constexpr size_t WS_CAT = 496 * MiB;
constexpr size_t WS_OPART = 624 * MiB;
constexpr size_t WS_ML = 816 * MiB;
constexpr size_t WS_H = 224 * MiB;
constexpr size_t WS_END = 822 * MiB;
static_assert(WS_PROJ + (size_t)M * PP * 2 <= WS_CAT, "proj fits");

constexpr int RING_BYTES = 131072;
constexpr int LDS_BYTES = 147456;

#define LAS __attribute__((address_space(3)))
typedef unsigned short bf16;
typedef unsigned v4u __attribute__((ext_vector_type(4)));
typedef unsigned v2u __attribute__((ext_vector_type(2)));
typedef float f32x4 __attribute__((ext_vector_type(4)));
typedef float f32x2 __attribute__((ext_vector_type(2)));
typedef float f32x16 __attribute__((ext_vector_type(16)));
typedef short bf16x8 __attribute__((ext_vector_type(8)));
typedef short s16x4 __attribute__((ext_vector_type(4)));

__device__ __forceinline__ unsigned f2bf(float f) { unsigned u = __builtin_bit_cast(unsigned, f); return (u + 0x7fffu + ((u >> 16) & 1u)) >> 16; }
__device__ __forceinline__ unsigned pk2(float lo, float hi) { return f2bf(lo) | (f2bf(hi) << 16); }
__device__ __forceinline__ float bflo(unsigned w) { return __builtin_bit_cast(float, w << 16); }
__device__ __forceinline__ float bfhi(unsigned w) { return __builtin_bit_cast(float, w & 0xffff0000u); }
__device__ __forceinline__ float wave_sum(float v) {
#pragma unroll
    for (int o = 1; o < 64; o <<= 1) v += __shfl_xor(v, o);
    return v;
}

__device__ __forceinline__ void p0_transpose_item(const float* W, int ldw, int K, int N, bf16* WT, int row_off, int nscale, float sc, const float* kscale, LAS float* scr, int item, int lane) {
    const int nblk = N / 32, kb = item / nblk, nb = item % nblk, k0 = 64 * kb, n0 = 32 * nb;
    const float s = (n0 < nscale) ? sc : 1.0f;
    f32x4 wv[8];
#pragma unroll
    for (int i = 0; i < 8; ++i) wv[i] = *(const f32x4*)(W + (size_t)(k0 + 8 * i + (lane >> 3)) * ldw + n0 + 4 * (lane & 7));
#pragma unroll
    for (int i = 0; i < 8; ++i) { const float sk = kscale ? s * kscale[k0 + 8 * i + (lane >> 3)] : s; LAS float* d = scr + (8 * i + (lane >> 3)) * 33 + 4 * (lane & 7); d[0] = wv[i].x * sk; d[1] = wv[i].y * sk; d[2] = wv[i].z * sk; d[3] = wv[i].w * sk; }
    asm volatile("s_waitcnt lgkmcnt(0)" ::: "memory");
    const int c = lane & 7;
#pragma unroll
    for (int j = 0; j < 4; ++j) { const int n = (lane >> 3) + 8 * j; const LAS float* sp = scr + (8 * c) * 33 + n;
        v4u o; o.x = pk2(sp[0 * 33], sp[1 * 33]); o.y = pk2(sp[2 * 33], sp[3 * 33]); o.z = pk2(sp[4 * 33], sp[5 * 33]); o.w = pk2(sp[6 * 33], sp[7 * 33]);
        *(v4u*)(WT + (size_t)(row_off + n0 + n) * K + k0 + 8 * c) = o; }
    asm volatile("s_waitcnt lgkmcnt(0)" ::: "memory");
}
template <bool BF> __device__ __forceinline__ void rms_row(const float* xrow, const float* g, void* orow, int lane) {
    const f32x4* xr = (const f32x4*)xrow + lane; const f32x4* gr = (const f32x4*)g + lane;
    f32x4 v[8]; float s = 0.f;
#pragma unroll
    for (int j = 0; j < 8; ++j) { v[j] = xr[64 * j]; s += (v[j].x * v[j].x + v[j].y * v[j].y) + (v[j].z * v[j].z + v[j].w * v[j].w); }
    const float rstd = 1.0f / sqrtf(wave_sum(s) * (1.0f / DM) + EPS);
#pragma unroll
    for (int j = 0; j < 8; ++j) { const f32x4 gg = gr[64 * j]; const f32x4 o = v[j] * rstd * gg;
        if (BF) { v2u w; w.x = pk2(o.x, o.y); w.y = pk2(o.z, o.w); ((v2u*)orow)[64 * j + lane] = w; }
        else ((f32x4*)orow)[64 * j + lane] = o; }
}

constexpr int TILE_B = 8192;
constexpr int WAVE_LDS = 2 * TILE_B;
__device__ __forceinline__ int crow(int r, int hi) { return (r & 3) + 8 * (r >> 2) + 4 * hi; }
__device__ __forceinline__ int swz16(int row) { return ((row & 3) << 2) | ((row >> 2) & 3); }
__device__ __forceinline__ s16x4 vtr(const LAS char* p) { typedef short v4i16_t __attribute__((ext_vector_type(4))); return __builtin_bit_cast(s16x4, __builtin_amdgcn_ds_read_tr16_b64_v4i16((LAS v4i16_t*)p)); }
__device__ __forceinline__ unsigned cvtpk(float lo, float hi) { unsigned r; asm("v_cvt_pk_bf16_f32 %0, %1, %2" : "=v"(r) : "v"(lo), "v"(hi)); return r; }

constexpr int ATT_P = 3, ATT_R = 4, ATT_STEPS = 36, SLOT_B = 2 * TILE_B, OST_OFF = ATT_R * SLOT_B;
struct AttLane { int q, hi, kb, vb; float sl, b4; };
template <int KT> __device__ __forceinline__ void attn_tile(const LAS char* slot, const LAS char* ost, const AttLane& L, f32x16 (&o)[4], float& m, float& l) {
    f32x16 s;
#pragma unroll
    for (int e = 0; e < 16; ++e) s[e] = 0.f;
#pragma unroll
    for (int ss = 0; ss < 8; ++ss) {
        const bf16x8 kf = *(const LAS bf16x8*)(slot + (L.kb ^ (32 * ss))), qv = *(const LAS bf16x8*)(ost + (L.kb ^ (32 * ss)));
        s = __builtin_amdgcn_mfma_f32_32x32x16_bf16(kf, qv, s, 0, 0, 0); }
    s16x4 vr[4][4];
#pragma unroll
    for (int c = 0; c < 2; ++c)
#pragma unroll
        for (int kk = 0; kk < 4; ++kk) vr[c][kk] = vtr(slot + ((L.vb ^ (16 * ((4 * c) ^ (2 * (kk & 1))))) + 2048 * kk));
    const int dbase = L.q + 128 - 32 * KT;
    float mx = -INFINITY;
#pragma unroll
    for (int e = 0; e < 16; ++e) { float v = __builtin_fmaf(L.sl, (float)((e & 3) + 8 * (e >> 2)), s[e]);
        if (KT == 0 || KT == 4) { const int dl = dbase - crow(e, L.hi); v = (dl < 0 || dl > 128) ? -INFINITY : v; }
        s[e] = v; mx = fmaxf(mx, v); }
    mx += L.b4;
    { auto rr = __builtin_amdgcn_permlane32_swap(__float_as_uint(mx), __float_as_uint(mx), false, false); mx = fmaxf(__uint_as_float(rr[0]), __uint_as_float(rr[1])); }
    const float sd = L.sl * (float)dbase;
    const float mc = mx - sd;
    if (__any(mc > m + 8.0f)) {
        const float mn = fmaxf(m, mc), alpha = __builtin_amdgcn_exp2f(m - mn);
        m = mn; l *= alpha;
#pragma unroll
        for (int c = 0; c < 4; ++c)
#pragma unroll
            for (int e = 0; e < 16; ++e) o[c][e] *= alpha;
    }
    const float sh = m + sd - L.b4;
    float ps = 0.f;
#pragma unroll
    for (int e = 0; e < 16; ++e) { s[e] = __builtin_amdgcn_exp2f(s[e] - sh); ps += s[e]; }
    l += ps;
    v4u pw0, pw1;
    pw0.x = cvtpk(s[0], s[1]); pw0.y = cvtpk(s[2], s[3]); pw0.z = cvtpk(s[4], s[5]); pw0.w = cvtpk(s[6], s[7]);
    pw1.x = cvtpk(s[8], s[9]); pw1.y = cvtpk(s[10], s[11]); pw1.z = cvtpk(s[12], s[13]); pw1.w = cvtpk(s[14], s[15]);
    const bf16x8 pf0 = __builtin_bit_cast(bf16x8, pw0), pf1 = __builtin_bit_cast(bf16x8, pw1);
#pragma unroll
    for (int c = 2; c < 4; ++c)
#pragma unroll
        for (int kk = 0; kk < 4; ++kk) vr[c][kk] = vtr(slot + ((L.vb ^ (16 * ((4 * c) ^ (2 * (kk & 1))))) + 2048 * kk));
#pragma unroll
    for (int c = 0; c < 4; ++c) {
        const bf16x8 vf0 = (bf16x8){vr[c][0][0], vr[c][0][1], vr[c][0][2], vr[c][0][3], vr[c][1][0], vr[c][1][1], vr[c][1][2], vr[c][1][3]};
        const bf16x8 vf1 = (bf16x8){vr[c][2][0], vr[c][2][1], vr[c][2][2], vr[c][2][3], vr[c][3][0], vr[c][3][1], vr[c][3][2], vr[c][3][3]};
        o[c] = __builtin_amdgcn_mfma_f32_32x32x16_bf16(vf0, pf0, o[c], 0, 0, 0);
        o[c] = __builtin_amdgcn_mfma_f32_32x32x16_bf16(vf1, pf1, o[c], 0, 0, 0); }
    asm volatile("s_waitcnt lgkmcnt(0)" ::: "memory");
}

__device__ __forceinline__ void attn_wg_unit(const bf16* __restrict__ proj, bf16* __restrict__ opart, f32x2* __restrict__ ml, int wgu, LAS char* lds, int wave, int lane) {
    const int p = wgu >> 8, rem = wgu & 255, bh = rem >> 4, b = bh >> 3, h = bh & 7, blk0 = (rem & 15) * 32;
    const int ls = 2 * p, r = blk0 >> (9 - ls), ib0 = blk0 & ((512 >> ls) - 1);
    const int q = lane & 31, hi = lane >> 5;
    const size_t rowbase = (size_t)b * SEQ + r;
    AttLane L; L.q = q; L.hi = hi;
    L.sl = __builtin_amdgcn_exp2f(-(float)(h + 1)) * LOG2E * (float)(1 << ls);
    L.b4 = L.sl * (float)(4 * hi);
    LAS char* ost = lds + OST_OFF + wave * TILE_B;
    const int lr = lane >> 4, c0 = (lane & 15) ^ (lr << 2);
    const int swzq = swz16(q);
    L.kb = q * 256 + 16 * (hi ^ swzq);
    const int qq = (lane & 15) >> 2, pp = lane & 3, bk = (lane >> 4) & 1;
    L.vb = TILE_B + (4 * hi + qq) * 256 + 8 * (pp & 1) + 16 * ((2 * bk + (pp >> 1)) ^ hi ^ (qq << 2));
    const int ob = q * 256 + 8 * hi + 16 * swzq;
    const size_t rstep = ((size_t)PP * 2) << ls;
    const char* KVu = (const char*)(proj + rowbase * PP + POOLW + ATTW + h * HD) + (size_t)(4 * wave) * rstep;
    const unsigned voff = (unsigned)((((size_t)lr << ls) * PP + (c0 ^ (wave & 3)) * 8) * 2);
    const int kbmax = (512 >> ls) - 1;
#define ATT_DMA(t_) do { int kbi_ = ib0 - 4 + (t_); kbi_ = kbi_ < 0 ? 0 : (kbi_ > kbmax ? kbmax : kbi_); const char* ub_ = KVu + (size_t)(kbi_ * 32) * rstep + voff; \
        LAS char* sl_ = lds + ((t_) & (ATT_R - 1)) * SLOT_B + wave * 1024; \
        __builtin_amdgcn_global_load_lds((const unsigned*)ub_, (LAS unsigned*)sl_, 16, 0, 0); \
        __builtin_amdgcn_global_load_lds((const unsigned*)(ub_ + ATTW * 2), (LAS unsigned*)(sl_ + TILE_B), 16, 0, 0); } while (0)
    const char* Qu = (const char*)(proj + rowbase * PP + POOLW + h * HD);
    unsigned voffq[4];
#pragma unroll
    for (int x = 0; x < 4; ++x) voffq[x] = (unsigned)((((size_t)lr << ls) * PP + (c0 ^ x) * 8) * 2);
#define ATT_QDMA(j_) do { const char* uq_ = Qu + (size_t)((ib0 + (j_)) * 32) * rstep; _Pragma("unroll") for (int jj_ = 0; jj_ < 8; ++jj_) \
        __builtin_amdgcn_global_load_lds((const unsigned*)(uq_ + (size_t)(4 * jj_) * rstep + voffq[jj_ & 3]), (LAS unsigned*)(ost + jj_ * 1024), 16, 0, 0); } while (0)
#define ATT_TOP(VM_) do { asm volatile("s_waitcnt vmcnt(" #VM_ ")" ::: "memory"); __builtin_amdgcn_s_barrier(); asm volatile("" ::: "memory"); ATT_DMA(t + ATT_P); } while (0)
    asm volatile("s_waitcnt lgkmcnt(0)" ::: "memory");
    __builtin_amdgcn_s_barrier();
    asm volatile("" ::: "memory");
    ATT_QDMA(wave);
    ATT_DMA(0); ATT_DMA(1); ATT_DMA(2);
    int t = 0;
    for (int i = 0; i < wave; ++i) { ATT_TOP(4); ++t; }
    for (int blk = 0; blk < 4; ++blk) {
        const int jcur = wave + 8 * blk;
        float m = -1e30f, l = 0.f;
        f32x16 o[4];
#pragma unroll
        for (int c = 0; c < 4; ++c)
#pragma unroll
            for (int e = 0; e < 16; ++e) o[c][e] = 0.f;
        if (blk == 0) ATT_TOP(4); else ATT_TOP(21);
        asm volatile("s_waitcnt vmcnt(6)" ::: "memory");
        if (ib0 - 4 + t >= 0) attn_tile<0>(lds + (t & (ATT_R - 1)) * SLOT_B, ost, L, o, m, l);
        ++t;
        ATT_TOP(4); if (ib0 - 4 + t >= 0) attn_tile<1>(lds + (t & (ATT_R - 1)) * SLOT_B, ost, L, o, m, l); ++t;
        ATT_TOP(4); if (ib0 - 4 + t >= 0) attn_tile<2>(lds + (t & (ATT_R - 1)) * SLOT_B, ost, L, o, m, l); ++t;
        ATT_TOP(4); if (ib0 - 4 + t >= 0) attn_tile<3>(lds + (t & (ATT_R - 1)) * SLOT_B, ost, L, o, m, l); ++t;
        ATT_TOP(4); attn_tile<4>(lds + (t & (ATT_R - 1)) * SLOT_B, ost, L, o, m, l); ++t;
        if (t < ATT_STEPS) ATT_TOP(4);
        {
            float lt; { auto rr = __builtin_amdgcn_permlane32_swap(__float_as_uint(l), __float_as_uint(l), false, false); lt = __uint_as_float(rr[0]) + __uint_as_float(rr[1]); }
            const float inv = 1.0f / lt; const size_t qrow = rowbase + ((size_t)((ib0 + jcur) * 32 + q) << ls);
#pragma unroll
            for (int c = 0; c < 4; ++c)
#pragma unroll
                for (int g4 = 0; g4 < 4; ++g4) { v2u w; w.x = cvtpk(o[c][4 * g4] * inv, o[c][4 * g4 + 1] * inv); w.y = cvtpk(o[c][4 * g4 + 2] * inv, o[c][4 * g4 + 3] * inv);
                    *(LAS v2u*)(ost + (ob ^ (16 * (4 * c + g4)))) = w; }
            asm volatile("s_waitcnt lgkmcnt(0)" ::: "memory");
            bf16* Ob = opart + ((size_t)p * M + rowbase) * ATTW + h * HD;
#pragma unroll
            for (int j = 0; j < 8; ++j) { const v4u w = *(const LAS v4u*)(ost + j * 1024 + lane * 16);
                *(v4u*)(Ob + ((size_t)((ib0 + jcur) * 32 + 4 * j + lr) << ls) * ATTW + (c0 ^ (j & 3)) * 8) = w; }
            if (hi == 0) ml[((size_t)p * M + qrow) * NHEAD + h] = (f32x2){m, lt};
            asm volatile("s_waitcnt lgkmcnt(0)" ::: "memory");
        }
        if (t < ATT_STEPS) ++t;
        if (blk < 3) {
            ATT_QDMA(jcur + 8);
            ATT_TOP(21); ++t; ATT_TOP(21); ++t;
        } else {
            if (t < ATT_STEPS) { ATT_TOP(13); ++t; }
            if (t < ATT_STEPS) { ATT_TOP(13); ++t; }
        }
    }
    while (t < ATT_STEPS) { ATT_TOP(4); ++t; }
#undef ATT_TOP
#undef ATT_DMA
#undef ATT_QDMA
}

__device__ __forceinline__ void merge_row(const bf16* __restrict__ proj, const bf16* __restrict__ opart, const f32x2* __restrict__ ml, const float* __restrict__ gp, const float* __restrict__ ga,
                                          bf16* __restrict__ cat, int row, int lane) {
    const int t = row & (SEQ - 1), c0 = lane * 16;
    float y[16];
    {
        const int w = 2 << (lane >> 4), cnt = (t + 1 < w) ? t + 1 : w;
        float acc[16];
#pragma unroll
        for (int j = 0; j < 16; ++j) acc[j] = 0.f;
#pragma unroll
        for (int hb = 0; hb < 2; ++hb) {
            v4u za[8], zb[8];
#pragma unroll
            for (int i = 0; i < 8; ++i) { const int ii = 8 * hb + i; const v4u* zp = (const v4u*)(proj + (size_t)(row - (ii < cnt ? ii : 0)) * PP + c0); za[i] = zp[0]; zb[i] = zp[1]; }
#pragma unroll
            for (int i = 0; i < 8; ++i) {
                const int ii = 8 * hb + i; const v4u a = za[i], b = zb[i]; const float mk = (ii == 0) ? -(float)(cnt - 1) : ((ii < cnt) ? 1.0f : 0.0f);
                float f[16] = {bflo(a.x), bfhi(a.x), bflo(a.y), bfhi(a.y), bflo(a.z), bfhi(a.z), bflo(a.w), bfhi(a.w), bflo(b.x), bfhi(b.x), bflo(b.y), bfhi(b.y), bflo(b.z), bfhi(b.z), bflo(b.w), bfhi(b.w)};
#pragma unroll
                for (int j = 0; j < 16; ++j) acc[j] += mk * f[j];
            }
        }
        const float ic = 1.0f / (float)cnt;
#pragma unroll
        for (int j = 0; j < 16; ++j) y[j] = acc[j] * ic;
    }
    {
        float ss = 0.f;
#pragma unroll
        for (int j = 0; j < 16; ++j) ss += y[j] * y[j];
        const float rstd = 1.0f / sqrtf(wave_sum(ss) * (1.0f / POOLW) + EPS);
        const f32x4* g4 = (const f32x4*)(gp + c0);
        v4u o0, o1; const f32x4 ga0 = g4[0], ga1 = g4[1], ga2 = g4[2], ga3 = g4[3];
        o0.x = pk2(y[0] * rstd * ga0.x, y[1] * rstd * ga0.y); o0.y = pk2(y[2] * rstd * ga0.z, y[3] * rstd * ga0.w);
        o0.z = pk2(y[4] * rstd * ga1.x, y[5] * rstd * ga1.y); o0.w = pk2(y[6] * rstd * ga1.z, y[7] * rstd * ga1.w);
        o1.x = pk2(y[8] * rstd * ga2.x, y[9] * rstd * ga2.y); o1.y = pk2(y[10] * rstd * ga2.z, y[11] * rstd * ga2.w);
        o1.z = pk2(y[12] * rstd * ga3.x, y[13] * rstd * ga3.y); o1.w = pk2(y[14] * rstd * ga3.z, y[15] * rstd * ga3.w);
        v4u* cp = (v4u*)(cat + (size_t)row * DM + c0); cp[0] = o0; cp[1] = o1;
    }
    {
        const int hd = lane >> 3;
        const f32x2 s0 = ml[((size_t)0 * M + row) * NHEAD + hd], s1 = ml[((size_t)1 * M + row) * NHEAD + hd], s2 = ml[((size_t)2 * M + row) * NHEAD + hd];
        const float mx = fmaxf(s0.x, fmaxf(s1.x, s2.x));
        float w0 = __builtin_amdgcn_exp2f(s0.x - mx) * s0.y, w1 = __builtin_amdgcn_exp2f(s1.x - mx) * s1.y, w2 = __builtin_amdgcn_exp2f(s2.x - mx) * s2.y;
        const float iw = 1.0f / (w0 + w1 + w2); w0 *= iw; w1 *= iw; w2 *= iw;
#pragma unroll
        for (int j = 0; j < 16; ++j) y[j] = 0.f;
#pragma unroll
        for (int i = 0; i < 3; ++i) {
            const float wi = i == 0 ? w0 : (i == 1 ? w1 : w2);
            const v4u* op = (const v4u*)(opart + ((size_t)i * M + row) * ATTW + c0);
            const v4u a = op[0], b = op[1];
            float f[16] = {bflo(a.x), bfhi(a.x), bflo(a.y), bfhi(a.y), bflo(a.z), bfhi(a.z), bflo(a.w), bfhi(a.w), bflo(b.x), bfhi(b.x), bflo(b.y), bfhi(b.y), bflo(b.z), bfhi(b.z), bflo(b.w), bfhi(b.w)};
#pragma unroll
            for (int j = 0; j < 16; ++j) y[j] += wi * f[j];
        }
        float ss = 0.f;
#pragma unroll
        for (int j = 0; j < 16; ++j) ss += y[j] * y[j];
        const float rstd = 1.0f / sqrtf(wave_sum(ss) * (1.0f / ATTW) + EPS);
        const f32x4* g4 = (const f32x4*)(ga + c0);
        v4u o0, o1; const f32x4 ga0 = g4[0], ga1 = g4[1], ga2 = g4[2], ga3 = g4[3];
        o0.x = pk2(y[0] * rstd * ga0.x, y[1] * rstd * ga0.y); o0.y = pk2(y[2] * rstd * ga0.z, y[3] * rstd * ga0.w);
        o0.z = pk2(y[4] * rstd * ga1.x, y[5] * rstd * ga1.y); o0.w = pk2(y[6] * rstd * ga1.z, y[7] * rstd * ga1.w);
        o1.x = pk2(y[8] * rstd * ga2.x, y[9] * rstd * ga2.y); o1.y = pk2(y[10] * rstd * ga2.z, y[11] * rstd * ga2.w);
        o1.z = pk2(y[12] * rstd * ga3.x, y[13] * rstd * ga3.y); o1.w = pk2(y[14] * rstd * ga3.z, y[15] * rstd * ga3.w);
        v4u* cp = (v4u*)(cat + (size_t)row * DM + POOLW + c0); cp[0] = o0; cp[1] = o1;
    }
}

#define XB_TMO      128
#define XB_XCNT(j)  (256  + 64 * (j))
#define XB_XSUB(j)  (1280 + 64 * (j))
#define XB_XGEN(j)  (2304 + 64 * (j))
#define XB_TOP      3328
#define XB_TOPGEN   3392
#define XCD_BAR_WORDS 3456
#define XB_SPIN_CAP (1u << 18)

__device__ __forceinline__ unsigned xb_ld(unsigned* p)              { return __hip_atomic_load(p, __ATOMIC_RELAXED, __HIP_MEMORY_SCOPE_AGENT); }
__device__ __forceinline__ unsigned xb_add(unsigned* p, unsigned v) { return __hip_atomic_fetch_add(p, v, __ATOMIC_RELAXED, __HIP_MEMORY_SCOPE_AGENT); }
__device__ __forceinline__ unsigned xb_xcc_id() { return (unsigned)__builtin_amdgcn_s_getreg((3 << 11) | 20) & 0xFu; }
#define XB_SPIN(cond, bar) do { unsigned _sp = 0; while (cond) { __builtin_amdgcn_s_sleep(1); \
    if ((++_sp & 255u) == 0u) { if (xb_ld(&(bar)[XB_TMO])) break; if (_sp > XB_SPIN_CAP) { atomicAdd(&(bar)[XB_TMO], 1u); break; } } } } while (0)

struct XcdBarrier {
    unsigned* bar; unsigned x;
    volatile LAS unsigned* st;
};

__device__ __forceinline__ XcdBarrier xcd_barrier_post(unsigned* bar, volatile LAS unsigned* st) {
    XcdBarrier b; b.bar = bar; b.x = xb_xcc_id(); b.st = st;
    if (threadIdx.x == 0) (void)xb_add(&bar[XB_XCNT(b.x)], 1u);
    return b;
}
__device__ __forceinline__ void xcd_barrier_complete(unsigned* bar, unsigned x, unsigned& nloc, unsigned& nx) {
    const unsigned G = gridDim.x * gridDim.y * gridDim.z;
    unsigned sum, cnt, mine, sp = 0u;
    for (;;) {
        sum = 0u; cnt = 0u; mine = 0u;
#pragma unroll
        for (unsigned j = 0; j < 16; ++j) { const unsigned c = xb_ld(&bar[XB_XCNT(j)]); sum += c; cnt += (c > 0u) ? 1u : 0u; mine = (j == x) ? c : mine; }
        if (sum == G) break;
        __builtin_amdgcn_s_sleep(1);
        if ((++sp & 255u) == 0u) { if (xb_ld(&bar[XB_TMO])) break; if (sp > XB_SPIN_CAP) { atomicAdd(&bar[XB_TMO], 1u); break; } }
    }
    nloc = mine > 0u ? mine : 1u; nx = cnt > 0u ? cnt : 1u;
}

__device__ __forceinline__ void xcd_barrier(const XcdBarrier& b) {
    asm volatile("s_waitcnt vmcnt(0)" ::: "memory");
    __syncthreads();
    if (threadIdx.x == 0) {
        unsigned* bar = b.bar;
        __builtin_amdgcn_s_waitcnt(0);
        unsigned nloc = b.st[0], nx = b.st[1];
        if (nloc == 0u) { xcd_barrier_complete(bar, b.x, nloc, nx); b.st[0] = nloc; b.st[1] = nx; }
        const unsigned old = xb_add(&bar[XB_XSUB(b.x)], 1u);
        const unsigned gen = old / nloc;
        if (old + 1u == (gen + 1u) * nloc) {
            __builtin_amdgcn_fence(__ATOMIC_RELEASE, "agent");
            asm volatile("s_waitcnt vmcnt(0)" ::: "memory");
            const unsigned og = xb_add(&bar[XB_TOP], 1u);
            const unsigned tg = og / nx;
            if (og + 1u == (tg + 1u) * nx) xb_add(&bar[XB_TOPGEN], 1u);
            else XB_SPIN(xb_ld(&bar[XB_TOPGEN]) == tg, bar);
            __builtin_amdgcn_fence(__ATOMIC_ACQUIRE, "agent");
            xb_add(&bar[XB_XGEN(b.x)], 1u);
            asm volatile("s_waitcnt vmcnt(0)" ::: "memory");
        } else {
            XB_SPIN(xb_ld(&bar[XB_XGEN(b.x)]) == gen, bar);
            __builtin_amdgcn_fence(__ATOMIC_ACQUIRE, "agent");
            asm volatile("s_waitcnt vmcnt(0)" ::: "memory");
        }
    }
    __syncthreads();
}

#ifndef MK_N_LAUNCHES
#define MK_N_LAUNCHES 1
#endif
constexpr int N_PHASES = 9;
#ifndef PROBE_SYNC
#define PROBE_SYNC 0
#endif
#ifndef PROBE_GEMM
#define PROBE_GEMM -1
#endif
#ifndef PROBE_VAR
#define PROBE_VAR 0
#endif
#ifndef PROBE_REP
#define PROBE_REP -1
#endif
#define REP(k) for (int rep_ = 0; rep_ < ((PROBE_REP) == (k) ? 2 : 1); ++rep_)
struct Args { const float* in[12]; float* out; unsigned char* ws; int ph_lo, ph_hi; };

__global__ void __launch_bounds__(NTHREADS, 2) fwd_mega(Args args) {
    extern __shared__ __attribute__((aligned(16))) unsigned char lds_raw[];
    LAS unsigned char* lds = (LAS unsigned char*)lds_raw;
    const int tid = threadIdx.x, lane = tid & 63, wave = __builtin_amdgcn_readfirstlane(tid >> 6);
    const int G = gridDim.x, bx = blockIdx.x;
    const int gw = bx * NWAVES + wave, NGW = G * NWAVES;
    unsigned char* ws = args.ws;
    const float* x = args.in[0]; const float* g_mix = args.in[1]; const float* w_in = args.in[2]; const float* pool_w = args.in[3]; const float* pool_scale = args.in[4];
    const float* g_pool = args.in[5]; const float* g_attn = args.in[6]; const float* w_out = args.in[7]; const float* g_mlp = args.in[8]; const float* w_up = args.in[9];
    const float* w_down = args.in[10]; const float* g_fin = args.in[11];
    float* out = args.out;
    bf16* WCAT = (bf16*)(ws + WS_WCAT); bf16* WOUT = (bf16*)(ws + WS_WOUT); bf16* WUP = (bf16*)(ws + WS_WUP); bf16* WDN = (bf16*)(ws + WS_WDN);
    bf16* XN = (bf16*)(ws + WS_XN); bf16* PROJ = (bf16*)(ws + WS_PROJ); bf16* CAT = (bf16*)(ws + WS_CAT); bf16* OPART = (bf16*)(ws + WS_OPART);
    f32x2* ML = (f32x2*)(ws + WS_ML); bf16* HB = (bf16*)(ws + WS_H); float* SSQ = (float*)(ws + WS_SSQ);
    const int lo = args.ph_lo, hi = args.ph_hi;
#define IN(k) (lo <= (k) && (k) < hi)
#define SEAM(k) do { if (IN(k) && IN((k) + 1)) { if ((k) == 0) { cg::this_grid().sync(); xbar = xcd_barrier_post((unsigned*)(ws + WS_BAR), (volatile LAS unsigned*)(lds + RING_BYTES + 320)); } else xcd_barrier(xbar); } } while (0)
    XcdBarrier xbar; xbar.bar = (unsigned*)(ws + WS_BAR); xbar.x = 0; xbar.st = (volatile LAS unsigned*)(lds + RING_BYTES + 320);
    if (lo == 0 && hi == N_PHASES) {
        if (bx == 0) for (int i = tid; i < XCD_BAR_WORDS; i += NTHREADS) __hip_atomic_store((unsigned*)(ws + WS_BAR) + i, 0u, __ATOMIC_RELAXED, __HIP_MEMORY_SCOPE_AGENT);
        if (tid < 2) ((volatile LAS unsigned*)(lds + RING_BYTES + 320))[tid] = 0u;
        __syncthreads();
    }

    if (IN(0)) REP(0) {
        const int pv0 = rep_ == 0 ? 0 : PROBE_VAR;
        for (int i = bx * NTHREADS + tid; i < 2 * M; i += G * NTHREADS) SSQ[i] = 0.f;
        if (pv0 == 0 || pv0 == 1)
        {
            LAS float* wt = (LAS float*)lds;
            const int f = tid & 255, kh = tid >> 8;
            for (int tile = bx; tile < 512; tile += G) {
                const int g = tile >> 7, k0 = (tile & 127) * 16;
#pragma unroll
                for (int j = 0; j < 8; ++j) { const int idx = tid + 512 * j, kk = idx >> 8, c = idx & 255; wt[kk * 256 + c] = w_in[(size_t)(k0 + kk) * INW + g * 256 + c]; }
                __syncthreads();
                float acc[8];
#pragma unroll
                for (int kk = 0; kk < 8; ++kk) acc[kk] = 0.f;
                const float* pw = pool_w + (size_t)g * 65536 + f;
                for (int cb = 0; cb < 256; cb += 32) {
                    float pv_[32];
#pragma unroll
                    for (int i = 0; i < 32; ++i) pv_[i] = pw[(cb + i) * 256];
#pragma unroll
                    for (int i = 0; i < 32; i += 4)
#pragma unroll
                        for (int kk = 0; kk < 8; ++kk) { const f32x4 v = *(const LAS f32x4*)(wt + (8 * kh + kk) * 256 + cb + i); acc[kk] += (pv_[i] * v.x + pv_[i + 1] * v.y) + (pv_[i + 2] * v.z + pv_[i + 3] * v.w); }
                }
                const float sc = pool_scale[g * 256 + f];
                v4u o; o.x = pk2(acc[0] * sc, acc[1] * sc); o.y = pk2(acc[2] * sc, acc[3] * sc); o.z = pk2(acc[4] * sc, acc[5] * sc); o.w = pk2(acc[6] * sc, acc[7] * sc);
                *(v4u*)(WCAT + (size_t)(g * 256 + f) * DM + k0 + 8 * kh) = o;
                __syncthreads();
            }
        }
        if (pv0 == 0 || pv0 == 2)
        {
            LAS float* scr = (LAS float*)(lds + wave * 16384);
            constexpr int I_QKV = (DM / 64) * (3 * ATTW / 32), I_O = (DM / 64) * (DM / 32), I_U = (DM / 64) * (DFF / 32), I_D = (DFF / 64) * (DM / 32);
            for (int it = gw; it < I_QKV + I_O + I_U + I_D; it += NGW) {
                int r = it;
                if (r < I_QKV) { p0_transpose_item(w_in + POOLW, INW, DM, 3 * ATTW, WCAT, POOLW, ATTW, QSCALE, nullptr, scr, r, lane); continue; } r -= I_QKV;
                if (r < I_O) { p0_transpose_item(w_out, DM, DM, DM, WOUT, 0, 0, 1.f, nullptr, scr, r, lane); continue; } r -= I_O;
                if (r < I_U) { p0_transpose_item(w_up, DFF, DM, DFF, WUP, 0, 0, 1.f, g_mlp, scr, r, lane); continue; } r -= I_U;
                p0_transpose_item(w_down, DM, DFF, DM, WDN, 0, 0, 1.f, nullptr, scr, r, lane);
            }
        }
        if (pv0 == 0 || pv0 == 3)
        for (int m = gw; m < M; m += NGW) rms_row<true>(x + (size_t)m * DM, g_mix, XN + (size_t)m * DM, lane);
    }
    SEAM(0);
    for (int xs_ = 0; xs_ < PROBE_SYNC; ++xs_) cg::this_grid().sync();
    if (IN(1)) REP(1) {
        __syncthreads();
        pg8::Gemm g{XN, WCAT, M, INW, DM}; pg8::RepOrder<(PROBE_GEMM == 1 ? 2 : 1)> S; S.init(M, INW, G, bx);
        pg8::EpiBf16Act<0> E{PROJ, PP, nullptr, 0.f, 0.f};
        pg8::gemm_phase<pg8::EpiBf16Act<0>, pg8::RepOrder<(PROBE_GEMM == 1 ? 2 : 1)>, PG8_ALIGN, PG8_SP2>(lds, g, S, E);
    }
    SEAM(1);
    if (IN(2)) REP(2) {
        for (int u = bx; u < 768; u += G) attn_wg_unit(PROJ, OPART, ML, u, (LAS char*)lds, wave, lane);
        asm volatile("s_waitcnt vmcnt(0)" ::: "memory");
        __syncthreads();
    }
    SEAM(2);
    if (IN(3)) REP(3) {
        for (int m = gw; m < M; m += NGW) merge_row(PROJ, OPART, ML, g_pool, g_attn, CAT, m, lane);
    }
    SEAM(3);
    if (IN(4)) REP(4) {
        __syncthreads();
        pg8::Gemm g{CAT, WOUT, M, DM, DM}; pg8::RepOrder<(PROBE_GEMM == 4 ? 2 : 1)> S; S.init(M, DM, G, bx);
        pg8::EpiResBf16<false> E{x, XN, DM, SSQ};
        pg8::gemm_phase<pg8::EpiResBf16<false>, pg8::RepOrder<(PROBE_GEMM == 4 ? 2 : 1)>, PG8_ALIGN, PG8_SP2>(lds, g, S, E);
    }
    SEAM(4);
    if (IN(6)) REP(6) {
        __syncthreads();
        pg8::Gemm g{XN, WUP, M, DFF, DM}; pg8::RepOrder<(PROBE_GEMM == 6 ? 2 : 1)> S; S.init(M, DFF, G, bx);
        pg8::EpiBf16Act<2> E{HB, DFF, SSQ, 1.0f / DM, EPS};
        pg8::gemm_phase<pg8::EpiBf16Act<2>, pg8::RepOrder<(PROBE_GEMM == 6 ? 2 : 1)>, PG8_ALIGN, PG8_SP2>(lds, g, S, E);
    }
    SEAM(6);
    if (IN(7)) REP(7) {
        __syncthreads();
        pg8::Gemm g{HB, WDN, M, DM, DFF}; pg8::StaticOrder S; S.init(M, DM, G, bx);
        pg8::EpiResBf16<true> E{XN, XN, DM, SSQ + M};
        pg8::gemm_phase<pg8::EpiResBf16<true>, pg8::StaticOrder, PG8_ALIGN, PG8_SP2>(lds, g, S, E);
    }
    SEAM(7);
    if (IN(8)) REP(8) {
        for (int m = gw; m < M; m += NGW) {
            const float rstd = 1.0f / sqrtf(SSQ[M + m] * (1.0f / DM) + EPS);
            const v4u* xr = (const v4u*)(XN + (size_t)m * DM) + lane; const f32x4* gr = (const f32x4*)g_fin + 2 * lane; f32x4* orow = (f32x4*)(out + (size_t)m * DM) + 2 * lane;
            v4u w[4];
#pragma unroll
            for (int j = 0; j < 4; ++j) w[j] = xr[64 * j];
#pragma unroll
            for (int j = 0; j < 4; ++j) { const f32x4 g0 = gr[128 * j], g1 = gr[128 * j + 1];
                orow[128 * j] = (f32x4){bflo(w[j].x) * rstd * g0.x, bfhi(w[j].x) * rstd * g0.y, bflo(w[j].y) * rstd * g0.z, bfhi(w[j].y) * rstd * g0.w};
                orow[128 * j + 1] = (f32x4){bflo(w[j].z) * rstd * g1.x, bfhi(w[j].z) * rstd * g1.y, bflo(w[j].w) * rstd * g1.z, bfhi(w[j].w) * rstd * g1.w}; }
        }
    }
#undef IN
#undef SEAM
}

extern "C" void kernel_launch(void* const* d_in, const int* in_sizes, int n_in, void* d_out, int out_size, void* d_ws, size_t ws_size, hipStream_t stream) {
    static int grid = 0;
    if (grid == 0) {
        if (n_in != 12 || in_sizes[0] != M * DM || out_size != M * DM || ws_size < WS_END) { fprintf(stderr, "kernel_launch: unexpected shapes (n_in %d, in0 %d, out %d, ws %zu); nothing launched\n", n_in, n_in > 0 ? in_sizes[0] : -1, out_size, ws_size); grid = -1; return; }
        int dev = 0, cus = 0, per_cu = 0;
        if (hipGetDevice(&dev) != hipSuccess || hipDeviceGetAttribute(&cus, hipDeviceAttributeMultiprocessorCount, dev) != hipSuccess) { fprintf(stderr, "kernel_launch: device query failed\n"); grid = -1; return; }
        if (hipFuncSetAttribute((const void*)fwd_mega, hipFuncAttributeMaxDynamicSharedMemorySize, LDS_BYTES) != hipSuccess) { fprintf(stderr, "kernel_launch: hipFuncSetAttribute failed\n"); grid = -1; return; }
        if (hipOccupancyMaxActiveBlocksPerMultiprocessor(&per_cu, (const void*)fwd_mega, NTHREADS, LDS_BYTES) != hipSuccess || per_cu < 1) { fprintf(stderr, "kernel_launch: occupancy query gave %d\n", per_cu); per_cu = 1; }
        (void)hipGetLastError();
        grid = cus * per_cu;
    }
    if (grid < 0) return;
    Args a{};
    for (int i = 0; i < 12; ++i) a.in[i] = (const float*)d_in[i];
    a.out = (float*)d_out; a.ws = (unsigned char*)d_ws;
#if MK_N_LAUNCHES == 1
    a.ph_lo = 0; a.ph_hi = N_PHASES;
    void* kargs[] = {&a};
    hipError_t e = hipLaunchCooperativeKernel((const void*)fwd_mega, dim3(grid), dim3(NTHREADS), kargs, LDS_BYTES, stream);
    if (e != hipSuccess) fprintf(stderr, "kernel_launch: cooperative launch failed: %s (grid %d)\n", hipGetErrorString(e), grid);
#else
    for (int ph = 0; ph < N_PHASES; ++ph) {
        a.ph_lo = ph; a.ph_hi = ph + 1;
        hipLaunchKernelGGL(fwd_mega, dim3(grid), dim3(NTHREADS), LDS_BYTES, stream, a);
    }
#endif
}
```
